# Optimizing an MI355X kernel written in HIP

```python
import math
import jax, jax.numpy as jnp
from jax import lax
import numpy as np

D_MODEL = 1024
BATCH = 8
SEQ = 4096
DEPTH = 2

HEAD_DIM = 64
A_HEADS = 6
A_PATTERNS = ((128, 1), (512, 4), (2048, 16))
B_HEADS = 5
B_QK_DIM = 32
B_V_DIM = 64
C_HEADS = 5
C_Q_RANK = 192
C_KV_RANK = 128
C_NOPE_DIM = 64
C_ROPE_DIM = 32
C_V_DIM = 64
C_ROPE_THETA = 10000.0
ROPE_THETA = 500000.0
ROPE_FRACTION = 4
IN_COLS = (A_HEADS * HEAD_DIM, A_HEADS * HEAD_DIM, A_HEADS * HEAD_DIM,
           B_HEADS * 2 * B_QK_DIM, B_HEADS * 2 * B_QK_DIM, B_HEADS * B_V_DIM,
           C_Q_RANK, C_KV_RANK, C_ROPE_DIM)
IN_WIDTH = sum(IN_COLS)
MIX_WIDTH = A_HEADS * HEAD_DIM + B_HEADS * B_V_DIM + C_HEADS * C_V_DIM
N_EXPERTS = 16
CAPACITY_FACTOR = 2
EXPERT_FF = 1408
Q_BLOCK = 128
NORM_EPS = 1e-6
SUBLN_EPS = 1e-5
NEG_INF = -1e30

kernel_name = 'hybrid_dilated_diff_mla_ec_encoder'


def rmsnorm(x, g, eps=NORM_EPS):
    xf = x.astype(jnp.float32)
    y = xf * lax.rsqrt(jnp.mean(xf * xf, axis=-1, keepdims=True) + eps)
    return (y * g.astype(jnp.float32)).astype(x.dtype)


def rope_angles(positions, rot_dim, theta):
    inv_freq = 1.0 / (theta ** (jnp.arange(0, rot_dim, 2, dtype=jnp.float32) / rot_dim))
    ang = positions.astype(jnp.float32)[:, :, None] * inv_freq
    return jnp.cos(ang)[:, :, None, :], jnp.sin(ang)[:, :, None, :]


def rotate(x, cos, sin):
    half = x.shape[-1] // 2
    x1 = x[..., :half].astype(jnp.float32)
    x2 = x[..., half:].astype(jnp.float32)
    return jnp.concatenate([x1 * cos - x2 * sin, x2 * cos + x1 * sin], axis=-1).astype(x.dtype)


def partial_rotate(x, cos, sin):
    r = 2 * cos.shape[-1]
    return jnp.concatenate([rotate(x[..., :r], cos, sin), x[..., r:]], axis=-1)


def dilated_window_stats(q, k, v, window, dilation):
    Bn, S, H, D = q.shape
    r = dilation
    n = window // (2 * dilation)
    L = S // r
    nb = -(-L // n)
    Lp = nb * n

    def residue_major(t):
        return t.reshape(Bn, L, r, H, D).transpose(0, 2, 3, 1, 4)

    qb = jnp.pad(residue_major(q), ((0, 0), (0, 0), (0, 0), (0, Lp - L), (0, 0))).reshape(Bn, r, H, nb, n, D)

    def key_windows(t):
        tp = jnp.pad(residue_major(t), ((0, 0), (0, 0), (0, 0), (n, Lp - L + n), (0, 0)))
        tp = tp.reshape(Bn, r, H, nb + 2, n, D)
        return jnp.concatenate([tp[:, :, :, :-2], tp[:, :, :, 1:-1], tp[:, :, :, 2:]], axis=4)

    kw = key_windows(k)
    vw = key_windows(v).astype(jnp.float32)
    s = jnp.einsum('brhiqd,brhikd->brhiqk', qb, kw, preferred_element_type=jnp.float32) * (D ** -0.5)
    qi = jnp.arange(n)[:, None]
    ki = jnp.arange(3 * n)[None, :]
    delta = ki - n - qi
    key_pos = jnp.arange(nb)[:, None, None] * n + ki[None] - n
    valid = (jnp.abs(delta) <= n)[None] & (key_pos >= 0) & (key_pos < L)
    s = jnp.where(valid, s, NEG_INF)
    m = jnp.max(s, axis=-1)
    p = jnp.exp(s - m[..., None])
    l = jnp.sum(p, axis=-1)
    o = jnp.einsum('brhiqk,brhikd->brhiqd', p, vw)

    def back(t):
        t = t.reshape((Bn, r, H, Lp) + t.shape[5:])[:, :, :, :L]
        t = jnp.moveaxis(t, 3, 1)
        return t.reshape((Bn, S, H) + t.shape[4:])

    return back(o), back(m), back(l)


def dilated_mixture_attention(q, k, v):
    stats = [dilated_window_stats(q, k, v, w, r) for (w, r) in A_PATTERNS]
    m_max = jnp.max(jnp.stack([st[1] for st in stats]), axis=0)
    num = 0.0
    den = 0.0
    for o, m, l in stats:
        e = jnp.exp(m - m_max)
        num = num + e[..., None] * o
        den = den + e * l
    return (num / den[..., None]).astype(q.dtype)


def to_blocks(t):
    Bn, S = t.shape[:2]
    return jnp.moveaxis(t.reshape((Bn, S // Q_BLOCK, Q_BLOCK) + t.shape[2:]), 1, 0)


def from_blocks(t):
    t = jnp.moveaxis(t, 0, 1)
    return t.reshape((t.shape[0], t.shape[1] * t.shape[2]) + t.shape[3:])


def differential_attention(q, k, v, lam):
    scale = q.shape[-1] ** -0.5
    vf = v.astype(jnp.float32)

    def one(qb):
        s = jnp.einsum('bqhcd,bkhcd->bhcqk', qb, k, preferred_element_type=jnp.float32) * scale
        p = jax.nn.softmax(s, axis=-1)
        w = p[:, :, 0] - lam * p[:, :, 1]
        return jnp.einsum('bhqk,bkhd->bqhd', w, vf)

    return from_blocks(lax.map(one, to_blocks(q))).astype(v.dtype)


def latent_attention(q_nope, q_rope, k_nope, k_rope, v):
    scale = (q_nope.shape[-1] + q_rope.shape[-1]) ** -0.5
    vf = v.astype(jnp.float32)

    def one(blk):
        qn, qr = blk
        s = (jnp.einsum('bqhd,bkhd->bhqk', qn, k_nope, preferred_element_type=jnp.float32)
             + jnp.einsum('bqhr,bkr->bhqk', qr, k_rope, preferred_element_type=jnp.float32)) * scale
        p = jax.nn.softmax(s, axis=-1)
        return jnp.einsum('bhqk,bkhd->bqhd', p, vf)

    return from_blocks(lax.map(one, (to_blocks(q_nope), to_blocks(q_rope)))).astype(v.dtype)


def hybrid_mixer(h, positions, w_in, lam_q1, lam_k1, lam_q2, lam_k2, diff_subln_g, lam_init,
                 q_norm_g, w_uq, kv_norm_g, w_ukv, a_out_g, c_out_g, w_out):
    Bn, S, _ = h.shape
    proj = jnp.einsum('bsd,de->bse', h, w_in)
    split_points = np.cumsum(IN_COLS)[:-1].tolist()
    aq, ak, av, bq, bk, bv, cq, ckv, ckr = jnp.split(proj, split_points, axis=-1)

    cos_a, sin_a = rope_angles(positions, HEAD_DIM // ROPE_FRACTION, ROPE_THETA)
    aq = partial_rotate(aq.reshape(Bn, S, A_HEADS, HEAD_DIM), cos_a, sin_a)
    ak = partial_rotate(ak.reshape(Bn, S, A_HEADS, HEAD_DIM), cos_a, sin_a)
    av = av.reshape(Bn, S, A_HEADS, HEAD_DIM)
    oa = dilated_mixture_attention(aq, ak, av)
    oa = rmsnorm(oa, a_out_g.reshape(A_HEADS, HEAD_DIM))

    cos_b, sin_b = rope_angles(positions, B_QK_DIM // ROPE_FRACTION, ROPE_THETA)
    bq = partial_rotate(bq.reshape(Bn, S, 2 * B_HEADS, B_QK_DIM), cos_b, sin_b).reshape(Bn, S, B_HEADS, 2, B_QK_DIM)
    bk = partial_rotate(bk.reshape(Bn, S, 2 * B_HEADS, B_QK_DIM), cos_b, sin_b).reshape(Bn, S, B_HEADS, 2, B_QK_DIM)
    bv = bv.reshape(Bn, S, B_HEADS, B_V_DIM)
    f32 = jnp.float32
    lam = (jnp.exp(jnp.sum(lam_q1.astype(f32) * lam_k1.astype(f32)))
           - jnp.exp(jnp.sum(lam_q2.astype(f32) * lam_k2.astype(f32))) + lam_init)
    ob = differential_attention(bq, bk, bv, lam)
    ob = rmsnorm(ob, diff_subln_g * (1.0 - lam_init), eps=SUBLN_EPS)

    cos_c, sin_c = rope_angles(positions, C_ROPE_DIM, C_ROPE_THETA)
    qc = jnp.einsum('bsr,re->bse', rmsnorm(cq, q_norm_g), w_uq).reshape(Bn, S, C_HEADS, C_NOPE_DIM + C_ROPE_DIM)
    q_nope = qc[..., :C_NOPE_DIM]
    q_rope = rotate(qc[..., C_NOPE_DIM:], cos_c, sin_c)
    kv = jnp.einsum('bsr,re->bse', rmsnorm(ckv, kv_norm_g), w_ukv).reshape(Bn, S, C_HEADS, C_NOPE_DIM + C_V_DIM)
    k_nope = kv[..., :C_NOPE_DIM]
    vc = kv[..., C_NOPE_DIM:]
    k_rope = rotate(ckr[:, :, None, :], cos_c, sin_c)[:, :, 0]
    oc = latent_attention(q_nope, q_rope, k_nope, k_rope, vc)
    oc = rmsnorm(oc, c_out_g.reshape(C_HEADS, C_V_DIM))

    o = jnp.concatenate([oa.reshape(Bn, S, -1), ob.reshape(Bn, S, -1), oc.reshape(Bn, S, -1)], axis=-1)
    return jnp.einsum('bse,ed->bsd', o, w_out)


def expert_choice_ffn(h, w_router, w_gate, w_up, w_down):
    Bn, S, D = h.shape
    cap = CAPACITY_FACTOR * S // N_EXPERTS
    logits = jnp.einsum('bsd,de->bse', h, w_router, preferred_element_type=jnp.float32)
    affinity = jax.nn.softmax(logits, axis=-1)
    gate, idx = lax.top_k(jnp.swapaxes(affinity, 1, 2), cap)
    xe = jax.vmap(lambda hb, ib: hb[ib])(h, idx)
    a = jnp.einsum('becd,edf->becf', xe, w_gate)
    u = jnp.einsum('becd,edf->becf', xe, w_up)
    y = jnp.einsum('becf,efd->becd', jax.nn.silu(a) * u, w_down)
    y = y * gate[..., None].astype(y.dtype)

    def scatter(yb, ib):
        return jnp.zeros((S, D), yb.dtype).at[ib.reshape(-1)].add(yb.reshape(-1, D))

    return jax.vmap(scatter)(y, idx)


def setup_inputs(seed: int = 0) -> dict:
    key = jax.random.key(seed)
    ks = jax.random.split(key, 24)
    f32 = jnp.float32

    def nrm(k, shape, fan_in):
        return jax.random.normal(k, shape, f32) * (fan_in ** -0.5)

    def gain(k, shape):
        return 1.0 + 0.02 * jax.random.normal(k, shape, f32)

    x = jax.random.normal(ks[0], (BATCH, SEQ, D_MODEL), f32)
    offsets = jax.random.randint(ks[1], (BATCH, 1), 0, 1024)
    positions = (jnp.arange(SEQ, dtype=jnp.int32)[None, :] + offsets).astype(jnp.int32)
    return {
        'x': x,
        'positions': positions,
        'attn_norm_g': gain(ks[2], (DEPTH, D_MODEL)),
        'w_in': nrm(ks[3], (DEPTH, D_MODEL, IN_WIDTH), D_MODEL),
        'lam_q1': 0.1 * jax.random.normal(ks[4], (DEPTH, B_QK_DIM), f32),
        'lam_k1': 0.1 * jax.random.normal(ks[5], (DEPTH, B_QK_DIM), f32),
        'lam_q2': 0.1 * jax.random.normal(ks[6], (DEPTH, B_QK_DIM), f32),
        'lam_k2': 0.1 * jax.random.normal(ks[7], (DEPTH, B_QK_DIM), f32),
        'diff_subln_g': gain(ks[8], (DEPTH, B_V_DIM)),
        'mla_q_norm_g': gain(ks[9], (DEPTH, C_Q_RANK)),
        'mla_w_uq': nrm(ks[10], (DEPTH, C_Q_RANK, C_HEADS * (C_NOPE_DIM + C_ROPE_DIM)), C_Q_RANK),
        'mla_kv_norm_g': gain(ks[11], (DEPTH, C_KV_RANK)),
        'mla_w_ukv': nrm(ks[12], (DEPTH, C_KV_RANK, C_HEADS * (C_NOPE_DIM + C_V_DIM)), C_KV_RANK),
        'dil_out_g': gain(ks[13], (DEPTH, A_HEADS * HEAD_DIM)),
        'mla_out_g': gain(ks[14], (DEPTH, C_HEADS * C_V_DIM)),
        'w_out': nrm(ks[15], (DEPTH, MIX_WIDTH, D_MODEL), MIX_WIDTH),
        'ffn_norm_g': gain(ks[16], (DEPTH, D_MODEL)),
        'w_router': nrm(ks[17], (DEPTH, D_MODEL, N_EXPERTS), D_MODEL),
        'w_gate': nrm(ks[18], (DEPTH, N_EXPERTS, D_MODEL, EXPERT_FF), D_MODEL),
        'w_up': nrm(ks[19], (DEPTH, N_EXPERTS, D_MODEL, EXPERT_FF), D_MODEL),
        'w_down': nrm(ks[20], (DEPTH, N_EXPERTS, EXPERT_FF, D_MODEL), EXPERT_FF),
        'final_norm_g': gain(ks[21], (D_MODEL,)),
    }


def reference(x, positions, attn_norm_g, w_in, lam_q1, lam_k1, lam_q2, lam_k2, diff_subln_g,
              mla_q_norm_g, mla_w_uq, mla_kv_norm_g, mla_w_ukv, dil_out_g, mla_out_g, w_out,
              ffn_norm_g, w_router, w_gate, w_up, w_down, final_norm_g):
    for l in range(DEPTH):
        lam_init = 0.8 - 0.6 * math.exp(-0.3 * l)
        h = rmsnorm(x, attn_norm_g[l])
        x = x + hybrid_mixer(h, positions, w_in[l], lam_q1[l], lam_k1[l], lam_q2[l], lam_k2[l],
                             diff_subln_g[l], lam_init, mla_q_norm_g[l], mla_w_uq[l],
                             mla_kv_norm_g[l], mla_w_ukv[l], dil_out_g[l], mla_out_g[l], w_out[l])
        h = rmsnorm(x, ffn_norm_g[l])
        x = x + expert_choice_ffn(h, w_router[l], w_gate[l], w_up[l], w_down[l])
    return rmsnorm(x, final_norm_g)
```

```cpp
#include <hip/hip_runtime.h>
#include <cstdio>
#include <cstdint>

typedef unsigned short bf16;
typedef float f32x4 __attribute__((ext_vector_type(4)));
typedef unsigned u32x4 __attribute__((ext_vector_type(4)));
typedef unsigned u32x2 __attribute__((ext_vector_type(2)));

constexpr int NB = 8, S = 4096, M = NB * S, D = 1024, DEPTH = 2;
constexpr int NIN = 2464, NINP = 2560;
constexpr int COL_AQ = 0, COL_AK = 384, COL_AV = 768, COL_BQ = 1152, COL_BK = 1472, COL_BV = 1792, COL_CQ = 2112, COL_CKV = 2304, COL_CKR = 2432;
constexpr int NUP = 1280, KUP = 384;
constexpr int UCOL_KV = 512;
constexpr int NE = 16, CAP = 512, FF = 1408, NGU = 2 * FF;
constexpr int MR = NE * NB * CAP;
constexpr int TABW = 56;
constexpr float LOG2E = 1.4426950408889634f;
constexpr float QS_A = 0.125f * LOG2E, QS_B = 0.17677669529663687f * LOG2E, QS_C = 0.10206207261596575f * LOG2E;

constexpr size_t MiB = 1u << 20;
constexpr size_t WS_CTL = 0, CTL_BYTES = 1 * MiB;
constexpr size_t WS_TAB = 1 * MiB;
constexpr size_t WS_AFF = 8 * MiB;
constexpr size_t WS_IDX = 10 * MiB;
constexpr size_t WS_GATE = 10 * MiB + 256 * 1024;
constexpr size_t WS_SEL = 10 * MiB + 512 * 1024;
constexpr size_t WS_RSTD = 13 * MiB;
constexpr size_t WS_RSTDA = 13 * MiB + 256 * 1024;
constexpr size_t WS_WIN = 14 * MiB;
constexpr size_t WS_WOUT = 19 * MiB;
constexpr size_t WS_WUP = 21 * MiB;
constexpr size_t WS_WGU = 22 * MiB;
constexpr size_t WS_WD = 110 * MiB;
constexpr size_t WS_X = 154 * MiB;
constexpr size_t WS_R1 = 282 * MiB;
constexpr size_t WS_R2 = 458 * MiB;
constexpr size_t WS_O = WS_R2 + 80 * MiB;
constexpr size_t WS_AP = 602 * MiB;
constexpr size_t AP_PO_BYTES = (size_t)3 * M * 6 * 64 * 2, AP_ML_BYTES = (size_t)3 * M * 6 * 4;
constexpr size_t WS_END = 682 * MiB;
static_assert(WS_AP + AP_PO_BYTES + 2 * AP_ML_BYTES <= WS_END, "ws map");

__device__ __forceinline__ unsigned f2bf(float f) { unsigned u = __builtin_bit_cast(unsigned, f); return (u + 0x7fffu + ((u >> 16) & 1u)) >> 16; }
__device__ __forceinline__ float bf2f(unsigned h) { return __builtin_bit_cast(float, h << 16); }
__device__ __forceinline__ unsigned pk2(float lo, float hi) { return f2bf(lo) | (f2bf(hi) << 16); }
__device__ __forceinline__ float wave_sum(float v) {
#pragma unroll
    for (int o = 1; o < 64; o <<= 1) v += __shfl_xor(v, o);
    return v;
}
__host__ __device__ __forceinline__ int perm16(int p) { return 4 * (p >> 3) + (p & 3) + 8 * ((p >> 2) & 1); }
__host__ __device__ __forceinline__ int perm32c(int p) { return 4 * (p >> 3) + (p & 3) + 16 * ((p >> 2) & 1); }
__host__ __device__ __forceinline__ int inproj_src(int n) {
    if (n >= NIN) return -1;
    if (n < COL_AV) { const int p = n & 63; return p < 16 ? (n - p) + perm16(p) : n; }
    if (n >= COL_CKR) return COL_CKR + perm32c(n - COL_CKR);
    return n;
}

#define GAS __attribute__((address_space(1)))
#define LAS __attribute__((address_space(3)))
enum { WM_IN = 0, WM_OUT = 1, WM_UP = 2, WM_GU = 3, WM_DN = 4 };
__device__ __forceinline__ void store8(bf16* p, const float* v) { u32x4 w; w.x = pk2(v[0], v[1]); w.y = pk2(v[2], v[3]); w.z = pk2(v[4], v[5]); w.w = pk2(v[6], v[7]); *(u32x4*)p = w; }
__device__ __forceinline__ void ld8(const bf16* p, float* v) { const u32x4 w = *(const u32x4*)p; v[0] = bf2f(w.x & 0xffffu); v[1] = bf2f(w.x >> 16); v[2] = bf2f(w.y & 0xffffu); v[3] = bf2f(w.y >> 16);
    v[4] = bf2f(w.z & 0xffffu); v[5] = bf2f(w.z >> 16); v[6] = bf2f(w.w & 0xffffu); v[7] = bf2f(w.w >> 16); }
namespace pg8 {
#define PG8_LAS __attribute__((address_space(3)))
typedef unsigned short bf16_t;
typedef short bf16x8 __attribute__((ext_vector_type(8)));
constexpr int BM = 256, BK = 64, HALF = 128, HTB = HALF * BK * 2  , STAGE_BYTES = 8 * HTB;
__host__ __device__ __forceinline__ int lds_byte(int r, int c) { const int st = (r >> 4) * 2 + (c >> 5), rr = r & 15, cc = c & 31, ob = rr * 64 + cc * 2; return st * 1024 + (ob ^ (((ob >> 9) & 1) << 5)); }
__host__ __device__ __forceinline__ void stage_rc(int b, int& R, int& C) { const int st = b / 1024, sb = b % 1024, swz = sb ^ (((sb >> 9) & 1) << 5); R = (st >> 1) * 16 + swz / 64; C = (st & 1) * 32 + (swz % 64) / 2; }
__host__ __device__ __forceinline__ int perm32(int rho) { const int n = rho >> 4, i = rho & 15; return 8 * (i >> 2) + 4 * n + (i & 3); }
struct Unit { int pm, pn; };
struct Gemm { const bf16_t* A; const bf16_t* Bt; int lda, ldb, K; };
template <bool GATHER_> struct PanelOrder {
    static constexpr bool GATHER = GATHER_;
    int pm, pn0, cnt; size_t a_tile, b_tile, b_base; const PG8_LAS int* rows;
    __device__ __forceinline__ bool next(int i, Unit& u) const { if (i >= cnt) return false; u.pm = pm; u.pn = pn0 + i; return true; }
    __device__ __forceinline__ size_t a_off(const Unit& u) const { return GATHER_ ? (size_t)0 : (size_t)u.pm * a_tile; }
    __device__ __forceinline__ size_t b_off(const Unit& u) const { return b_base + (size_t)u.pn * b_tile; }
    __device__ __forceinline__ const PG8_LAS int* rows_of(const Unit&) const { return rows; }
};
template <bool GATHER_> struct PairOrder {
    static constexpr bool GATHER = GATHER_;
    int pm0, h, nt, c0; size_t a_tile, b_tile, b_base; const PG8_LAS int* rows;
    __device__ __forceinline__ bool next(int i, Unit& u) const { if (i >= nt) return false; const int n0 = h ? nt - c0 : c0;
        if (i < n0) { u.pm = pm0; u.pn = (h ? c0 : 0) + i; } else { u.pm = pm0 + 1; u.pn = (h ? nt - c0 : 0) + (i - n0); } return true; }
    __device__ __forceinline__ size_t a_off(const Unit& u) const { return GATHER_ ? (size_t)0 : (size_t)u.pm * a_tile; }
    __device__ __forceinline__ size_t b_off(const Unit& u) const { return b_base + (size_t)u.pn * b_tile; }
    __device__ __forceinline__ const PG8_LAS int* rows_of(const Unit& u) const { return rows + 256 * (u.pm & 1); }
};
__device__ __forceinline__ unsigned cvt_pk_bf16(float lo, float hi) { unsigned r; asm volatile("v_cvt_pk_bf16_f32 %0, %1, %2" : "=v"(r) : "v"(lo), "v"(hi)); return r; }
__device__ __forceinline__ void rope4(f32x4& v0, f32x4& v1, const float* cs, const float* sn) {
    const f32x4 c = *(const f32x4*)cs, s = *(const f32x4*)sn; const f32x4 a = v0 * c - v1 * s, b = v1 * c + v0 * s; v0 = a; v1 = b; }
struct EpiIn {
    static constexpr bool PERM = true, AFTER_DRAIN = false, INIT_LOAD = false;
    bf16_t* P; const float* tab; const float* RSA;
    __device__ __forceinline__ void operator()(const f32x4 (&acc)[2][2][4][2], const Unit& u, int wr, int wc, int fr_, int fq_) const {
        int fr = fr_, fq = fq_; asm volatile("" : "+v"(fr), "+v"(fq));
        const int row0 = u.pm * BM + wr * 64 + fr;
        float rsa[2][4];
#pragma unroll
        for (int ai = 0; ai < 2; ++ai)
#pragma unroll
            for (int m = 0; m < 4; ++m) rsa[ai][m] = RSA[row0 + ai * HALF + m * 16];
#pragma unroll
        for (int bj = 0; bj < 2; ++bj) {
            const int gcol = u.pn * BM + bj * HALF + wc * 32;
            int cso = -1, sno = 0; float sc = 1.f; bool grope = false;
            if (gcol < COL_AV) { grope = (gcol & 63) == 0; if (grope && fq < 2) { cso = 4 * fq; sno = 8 + 4 * fq; } if (gcol < COL_AK) sc = QS_A; }
            else if (gcol >= COL_BQ && gcol < COL_BV) { grope = true; if (fq == 0) { cso = 16; sno = 20; } if (gcol < COL_BK) sc = QS_B; }
            else if (gcol == COL_CKR) { grope = true; cso = 24 + 4 * fq; sno = 40 + 4 * fq; }
            const int co = cso >= 0 ? cso : 0;
#pragma unroll
            for (int ai = 0; ai < 2; ++ai) {
                f32x4 cs[4], sn[4];
                if (grope) {
#pragma unroll
                    for (int m = 0; m < 4; ++m) { const float* tb = tab + (size_t)(row0 + ai * HALF + m * 16) * TABW; cs[m] = *(const f32x4*)(tb + co); sn[m] = *(const f32x4*)(tb + sno); } }
#pragma unroll
                for (int m = 0; m < 4; ++m) { const int t = row0 + ai * HALF + m * 16; f32x4 v0 = acc[ai][bj][m][0], v1 = acc[ai][bj][m][1];
                    if (grope && cso >= 0) { const f32x4 a = v0 * cs[m] - v1 * sn[m], b = v1 * cs[m] + v0 * sn[m]; v0 = a; v1 = b; }
                    const float scr = sc * rsa[ai][m]; v0 = v0 * scr; v1 = v1 * scr;
                    u32x4 w; w.x = cvt_pk_bf16(v0[0], v0[1]); w.y = cvt_pk_bf16(v0[2], v0[3]); w.z = cvt_pk_bf16(v1[0], v1[1]); w.w = cvt_pk_bf16(v1[2], v1[3]);
                    *(u32x4*)(P + (size_t)t * NINP + gcol + 8 * fq) = w; }
                asm volatile("" ::: "memory"); }
        }
    }
};
struct EpiUp {
    static constexpr bool PERM = true, AFTER_DRAIN = false, INIT_LOAD = false;
    bf16_t* U; const float* tab; const PG8_LAS float* rs;
    __device__ __forceinline__ void operator()(const f32x4 (&acc)[2][2][4][2], const Unit& u, int wr, int wc, int fr_, int fq_) const {
        int fr = fr_, fq = fq_; asm volatile("" : "+v"(fr), "+v"(fq));
        const int lr0 = wr * 64 + fr;
#pragma unroll
        for (int bj = 0; bj < 2; ++bj) {
            const int gcol = u.pn * BM + bj * HALF + wc * 32; const bool isq = gcol < UCOL_KV; const bool rope = gcol < 480 && ((gcol >> 5) % 3) == 2;
#pragma unroll
            for (int ai = 0; ai < 2; ++ai) {
                f32x4 cs[4], sn[4];
                if (rope) {
#pragma unroll
                    for (int m = 0; m < 4; ++m) { const float* tb = tab + (size_t)(u.pm * BM + lr0 + ai * HALF + m * 16) * TABW; cs[m] = *(const f32x4*)(tb + 24 + 4 * fq); sn[m] = *(const f32x4*)(tb + 40 + 4 * fq); } }
#pragma unroll
                for (int m = 0; m < 4; ++m) { const int lr = lr0 + ai * HALF + m * 16, t = u.pm * BM + lr; f32x4 v0 = acc[ai][bj][m][0], v1 = acc[ai][bj][m][1];
                    const float sc = rs[2 * lr + (isq ? 0 : 1)];
                    if (rope) { const f32x4 a = v0 * cs[m] - v1 * sn[m], b = v1 * cs[m] + v0 * sn[m]; v0 = a; v1 = b; }
                    v0 = v0 * sc; v1 = v1 * sc;
                    u32x4 w; w.x = cvt_pk_bf16(v0[0], v0[1]); w.y = cvt_pk_bf16(v0[2], v0[3]); w.z = cvt_pk_bf16(v1[0], v1[1]); w.w = cvt_pk_bf16(v1[2], v1[3]);
                    *(u32x4*)(U + (size_t)t * NUP + gcol + 8 * fq) = w; }
                asm volatile("" ::: "memory"); }
        }
    }
};
struct EpiOut {
    static constexpr bool PERM = true, AFTER_DRAIN = false, INIT_LOAD = true;
    bf16_t* XB; const float* XI;
    __device__ __forceinline__ void load_init(f32x4 (&acc)[2][2][4][2], const Unit& u, int wr, int wc, int fr_, int fq_) const {
        int fr = fr_, fq = fq_; asm volatile("" : "+v"(fr), "+v"(fq));
        const int row0 = u.pm * BM + wr * 64 + fr, col0 = u.pn * BM + wc * 32 + 8 * fq;
#pragma unroll
        for (int ai = 0; ai < 2; ++ai)
#pragma unroll
            for (int m = 0; m < 4; ++m) { const size_t off = (size_t)(row0 + ai * HALF + m * 16) * D + col0;
#pragma unroll
                for (int bj = 0; bj < 2; ++bj) {
                    if (XI) { acc[ai][bj][m][0] = *(const f32x4*)(XI + off + bj * HALF); acc[ai][bj][m][1] = *(const f32x4*)(XI + off + bj * HALF + 4); }
                    else { const u32x4 w = *(const u32x4*)(XB + off + bj * HALF);
                        acc[ai][bj][m][0] = (f32x4){bf2f(w.x & 0xffffu), bf2f(w.x >> 16), bf2f(w.y & 0xffffu), bf2f(w.y >> 16)}; acc[ai][bj][m][1] = (f32x4){bf2f(w.z & 0xffffu), bf2f(w.z >> 16), bf2f(w.w & 0xffffu), bf2f(w.w >> 16)}; } } }
    }
    __device__ __forceinline__ void operator()(const f32x4 (&acc)[2][2][4][2], const Unit& u, int wr, int wc, int fr_, int fq_) const {
        int fr = fr_, fq = fq_; asm volatile("" : "+v"(fr), "+v"(fq));
        const int row0 = u.pm * BM + wr * 64 + fr, col0 = u.pn * BM + wc * 32 + 8 * fq;
#pragma unroll
        for (int ai = 0; ai < 2; ++ai)
#pragma unroll
            for (int m = 0; m < 4; ++m) { bf16_t* rowp = XB + (size_t)(row0 + ai * HALF + m * 16) * D + col0;
#pragma unroll
                for (int bj = 0; bj < 2; ++bj) { const f32x4 v0 = acc[ai][bj][m][0], v1 = acc[ai][bj][m][1];
                    u32x4 w; w.x = cvt_pk_bf16(v0[0], v0[1]); w.y = cvt_pk_bf16(v0[2], v0[3]); w.z = cvt_pk_bf16(v1[0], v1[1]); w.w = cvt_pk_bf16(v1[2], v1[3]);
                    *(u32x4*)(rowp + bj * HALF) = w; } }
    }
};
struct EpiG1 {
    static constexpr bool PERM = true, AFTER_DRAIN = false, INIT_LOAD = false;
    bf16_t* ACT; const float* RSTD; const PG8_LAS int* rows;
    __device__ __forceinline__ void operator()(const f32x4 (&acc)[2][2][4][2], const Unit& u, int wr, int wc, int fr_, int fq_) const {
        int fr = fr_, fq = fq_; asm volatile("" : "+v"(fr), "+v"(fq));
        const int row0 = u.pm * BM + wr * 64 + fr, col0 = u.pn * HALF + wc * 32 + 8 * fq;
        float rsdv[2][4];
#pragma unroll
        for (int ai = 0; ai < 2; ++ai)
#pragma unroll
            for (int m = 0; m < 4; ++m) rsdv[ai][m] = RSTD[rows[(u.pm & 1) * BM + ai * HALF + wr * 64 + m * 16 + fr]];
#pragma unroll
        for (int ai = 0; ai < 2; ++ai)
#pragma unroll
            for (int m = 0; m < 4; ++m) { float a[8]; const float rsd = rsdv[ai][m];
#pragma unroll
                for (int n = 0; n < 2; ++n)
#pragma unroll
                    for (int j = 0; j < 4; ++j) { const float g = acc[ai][0][m][n][j] * rsd, up = acc[ai][1][m][n][j] * rsd;
                        a[4 * n + j] = g * __builtin_amdgcn_rcpf(1.0f + __builtin_amdgcn_exp2f(-g * LOG2E)) * up; }
                u32x4 w; w.x = cvt_pk_bf16(a[0], a[1]); w.y = cvt_pk_bf16(a[2], a[3]); w.z = cvt_pk_bf16(a[4], a[5]); w.w = cvt_pk_bf16(a[6], a[7]);
                *(u32x4*)(ACT + (size_t)(row0 + ai * HALF + m * 16) * FF + col0) = w; }
    }
};
struct EpiBf16 {
    static constexpr bool PERM = true, AFTER_DRAIN = false, INIT_LOAD = false;
    bf16_t* O; int ldc;
    __device__ __forceinline__ void operator()(const f32x4 (&acc)[2][2][4][2], const Unit& u, int wr, int wc, int fr_, int fq_) const {
        int fr = fr_, fq = fq_; asm volatile("" : "+v"(fr), "+v"(fq));
        const int row0 = u.pm * BM + wr * 64 + fr, col0 = u.pn * BM + wc * 32 + 8 * fq;
#pragma unroll
        for (int ai = 0; ai < 2; ++ai)
#pragma unroll
            for (int m = 0; m < 4; ++m) { bf16_t* rowp = O + (size_t)(row0 + ai * HALF + m * 16) * ldc + col0;
#pragma unroll
                for (int bj = 0; bj < 2; ++bj) { const f32x4 v0 = acc[ai][bj][m][0], v1 = acc[ai][bj][m][1];
                    u32x4 w; w.x = cvt_pk_bf16(v0[0], v0[1]); w.y = cvt_pk_bf16(v0[2], v0[3]); w.z = cvt_pk_bf16(v1[0], v1[1]); w.w = cvt_pk_bf16(v1[2], v1[3]);
                    *(u32x4*)(rowp + bj * HALF) = w; } }
    }
};

template <class Epi, class Sched, bool ALIGN_EPI>
__device__ __forceinline__ void gemm_phase(PG8_LAS unsigned char* lds, const Gemm g, const Sched& S, const Epi& E, int tid_in) {
    int tid_ = tid_in; asm volatile("" : "+v"(tid_));
    const int tid = tid_, wid = __builtin_amdgcn_readfirstlane(tid >> 6), lane = tid & 63, wr = wid >> 2, wc = wid & 3, fr = lane & 15, fq = lane >> 4;
    const int K = g.K, nt = K / BK;
    unsigned voffA0[2], voffA1[2], voffB[2];
    Unit cur, nxt; int ui = 0;
    if (!S.next(0, cur)) return;
#pragma unroll
    for (int i = 0; i < 2; ++i) { int R, C; stage_rc(tid * 16 + i * 8192, R, C); const int Rb = Epi::PERM ? ((R & ~31) + perm32(R & 31)) : R;
        if constexpr (Sched::GATHER) { const PG8_LAS int* rw = S.rows_of(cur); voffA0[i] = (unsigned)rw[R] * (unsigned)(g.lda * 2) + (unsigned)C * 2u; voffA1[i] = (unsigned)rw[R + HALF] * (unsigned)(g.lda * 2) + (unsigned)C * 2u; }
        else { voffA0[i] = (unsigned)(R * g.lda + C) * 2u; voffA1[i] = 0u; }
        voffB[i] = (unsigned)(Rb * g.ldb + C) * 2u; }
    const size_t kstep = (size_t)(BK * 2);
    const size_t hstepB = (size_t)HALF * g.ldb * 2;
    const size_t hstepA = Sched::GATHER ? (size_t)0 : (size_t)HALF * g.lda * 2;
#define PG8_STAGE_A1(bufoff, gbase) do { if constexpr (Sched::GATHER) PG8_STAGE(bufoff, gbase, voffA1); else PG8_STAGE(bufoff, (gbase) + hstepA, voffA0); } while (0)
    const unsigned ldsw = (unsigned)wid * 1024u;
    const int aoff = lds_byte(wr * 64 + fr, fq * 8), boff = lds_byte(wc * 32 + fr, fq * 8);
#define PG8_SA(b, h) (((b) * 2 + (h)) * HTB)
#define PG8_SB(b, h) ((4 + (b) * 2 + (h)) * HTB)
#define PG8_STAGE(bufoff, gbase, voff) do { _Pragma("unroll") for (int _i = 0; _i < 2; ++_i) \
        __builtin_amdgcn_global_load_lds((const unsigned*)((const char*)(gbase) + (voff)[_i]), (PG8_LAS unsigned*)(lds + (bufoff) + ldsw + _i * 8192), 16, 0, 0); } while (0)
#define PG8_LDA(dst, b, h) do { _Pragma("unroll") for (int m = 0; m < 4; ++m) _Pragma("unroll") for (int k = 0; k < 2; ++k) dst[m][k] = *(const PG8_LAS bf16x8*)(lds + PG8_SA(b, h) + aoff + m * 2048 + k * 1024); } while (0)
#define PG8_LDB(dst, b, h) do { _Pragma("unroll") for (int n = 0; n < 2; ++n) _Pragma("unroll") for (int k = 0; k < 2; ++k) dst[n][k] = *(const PG8_LAS bf16x8*)(lds + PG8_SB(b, h) + boff + n * 2048 + k * 1024); } while (0)
#define PG8_MMA(ai, bj, At, Bt) do { __builtin_amdgcn_s_setprio(1); _Pragma("unroll") for (int m = 0; m < 4; ++m) _Pragma("unroll") for (int n = 0; n < 2; ++n) _Pragma("unroll") for (int k = 0; k < 2; ++k) \
        acc[ai][bj][m][n] = __builtin_amdgcn_mfma_f32_16x16x32_bf16(Bt[n][k], At[m][k], acc[ai][bj][m][n], 0, 0, 0); __builtin_amdgcn_s_setprio(0); } while (0)
#define PG8_WAIT_V(n) asm volatile("s_waitcnt vmcnt(" #n ")" ::: "memory")
#define PG8_WAIT_L(n) asm volatile("s_waitcnt lgkmcnt(" #n ")" ::: "memory")
#define PG8_BAR __builtin_amdgcn_s_barrier()
#define PG8_SCHED __builtin_amdgcn_sched_barrier(0)
    f32x4 acc[2][2][4][2];
    if constexpr (Epi::INIT_LOAD) E.load_init(acc, cur, wr, wc, fr, fq);
    else {
#pragma unroll
    for (int a = 0; a < 2; ++a)
#pragma unroll
        for (int b = 0; b < 2; ++b)
#pragma unroll
            for (int m = 0; m < 4; ++m)
#pragma unroll
                for (int n = 0; n < 2; ++n) acc[a][b][m][n] = (f32x4){0.f, 0.f, 0.f, 0.f};
    }
    bf16x8 At[4][2], B0[2][2], B1[2][2];
    const char* cA = (const char*)g.A + S.a_off(cur); const char* cB = (const char*)g.Bt + S.b_off(cur);
    PG8_STAGE(PG8_SB(0, 0), cB, voffB); PG8_STAGE(PG8_SB(0, 1), cB + hstepB, voffB); PG8_STAGE(PG8_SA(0, 0), cA, voffA0); PG8_STAGE_A1(PG8_SA(0, 1), cA);
    if (wr == 1) PG8_BAR;
    PG8_WAIT_V(2); PG8_BAR;
    PG8_STAGE(PG8_SB(1, 0), cB + kstep, voffB); PG8_STAGE(PG8_SA(1, 0), cA + kstep, voffA0); PG8_STAGE(PG8_SB(1, 1), cB + hstepB + kstep, voffB);
    PG8_WAIT_V(6); PG8_BAR;
    for (;;) {
        const bool has_next = S.next(ui + 1, nxt);
        const char* nA = has_next ? (const char*)g.A + S.a_off(nxt) : cA; const char* nB = has_next ? (const char*)g.Bt + S.b_off(nxt) : cB;
#pragma unroll 1
        for (int t = 0; t < nt; t += 2) {
            const bool last = (t == nt - 2);
            const char* a1 = cA + (size_t)(t + 1) * kstep;
            const char* a2 = last ? nA : cA + (size_t)(t + 2) * kstep; const char* b2 = last ? nB : cB + (size_t)(t + 2) * kstep;
            const char* a3 = a2 + kstep; const char* b3 = b2 + kstep;
            PG8_LDB(B0, 0, 0); PG8_LDB(B1, 0, 1); PG8_SCHED; PG8_LDA(At, 0, 0); PG8_STAGE_A1(PG8_SA(1, 1), a1);
            if constexpr (Sched::GATHER) { if (last && has_next && nxt.pm != cur.pm) {
                const PG8_LAS int* rw = S.rows_of(nxt); const int tid2 = wid * 64 + (int)__builtin_amdgcn_mbcnt_hi(~0u, __builtin_amdgcn_mbcnt_lo(~0u, 0u));
#pragma unroll
                for (int i = 0; i < 2; ++i) { int R, C; stage_rc(tid2 * 16 + i * 8192, R, C); voffA0[i] = (unsigned)rw[R] * (unsigned)(g.lda * 2) + (unsigned)C * 2u; voffA1[i] = (unsigned)rw[R + HALF] * (unsigned)(g.lda * 2) + (unsigned)C * 2u; } } }
            PG8_WAIT_V(8); PG8_WAIT_L(0); PG8_BAR; PG8_MMA(0, 0, At, B0); PG8_MMA(0, 1, At, B1); PG8_BAR; PG8_SCHED;
            PG8_LDA(At, 0, 1); PG8_STAGE(PG8_SB(0, 0), b2, voffB); PG8_STAGE(PG8_SB(0, 1), b2 + hstepB, voffB); PG8_STAGE(PG8_SA(0, 0), a2, voffA0);
            PG8_WAIT_V(8); PG8_WAIT_L(0); PG8_BAR; PG8_MMA(1, 0, At, B0); PG8_MMA(1, 1, At, B1); PG8_BAR; PG8_SCHED;
            PG8_LDB(B0, 1, 0); PG8_LDB(B1, 1, 1); PG8_SCHED; PG8_LDA(At, 1, 0); PG8_STAGE_A1(PG8_SA(0, 1), a2);
            PG8_WAIT_V(8); PG8_WAIT_L(0); PG8_BAR; PG8_MMA(0, 0, At, B0); PG8_MMA(0, 1, At, B1); PG8_BAR; PG8_SCHED;
            PG8_LDA(At, 1, 1); PG8_STAGE(PG8_SB(1, 0), b3, voffB); PG8_STAGE(PG8_SB(1, 1), b3 + hstepB, voffB); PG8_STAGE(PG8_SA(1, 0), a3, voffA0);
            PG8_WAIT_V(8); PG8_WAIT_L(0); PG8_BAR; PG8_MMA(1, 0, At, B0); PG8_MMA(1, 1, At, B1); PG8_BAR; PG8_SCHED;
        }
        if constexpr (ALIGN_EPI) { if (wr == 0) PG8_BAR; }
        E(acc, cur, wr, wc, fr, fq);
        if (!has_next) break;
        if constexpr (Epi::INIT_LOAD) E.load_init(acc, nxt, wr, wc, fr, fq);
        else {
#pragma unroll
        for (int a = 0; a < 2; ++a)
#pragma unroll
            for (int b = 0; b < 2; ++b)
#pragma unroll
                for (int m = 0; m < 4; ++m)
#pragma unroll
                    for (int n = 0; n < 2; ++n) acc[a][b][m][n] = (f32x4){0.f, 0.f, 0.f, 0.f};
        }
        cur = nxt; cA = nA; cB = nB; ++ui;
        if constexpr (ALIGN_EPI) { if (wr == 1) PG8_BAR; }
    }
    PG8_WAIT_V(0);
    if constexpr (!ALIGN_EPI) { if (wr == 0) PG8_BAR; }
    PG8_BAR;
#undef PG8_SA
#undef PG8_SB
#undef PG8_STAGE
#undef PG8_STAGE_A1
#undef PG8_LDA
#undef PG8_LDB
#undef PG8_MMA
#undef PG8_WAIT_V
#undef PG8_WAIT_L
#undef PG8_BAR
#undef PG8_SCHED
}
}

#define XB_TMO      128
#define XB_XCNT(j)  (256  + 64 * (j))
#define XB_XSUB(j)  (1280 + 64 * (j))
#define XB_XGEN(j)  (2304 + 64 * (j))
#define XB_TOP      3328
#define XB_TOPGEN   3392
#define XCD_BAR_WORDS 3456
#define XB_SPIN_CAP (1u << 24)

__device__ __forceinline__ unsigned xb_ld(unsigned* p)              { return __hip_atomic_load(p, __ATOMIC_RELAXED, __HIP_MEMORY_SCOPE_AGENT); }
__device__ __forceinline__ unsigned xb_add(unsigned* p, unsigned v) { return __hip_atomic_fetch_add(p, v, __ATOMIC_RELAXED, __HIP_MEMORY_SCOPE_AGENT); }
__device__ __forceinline__ unsigned xb_xcc_id() { return (unsigned)__builtin_amdgcn_s_getreg((3 << 11) | 20) & 0xFu; }
#define XB_SPIN(cond, bar) do { unsigned _sp = 0; while (cond) { __builtin_amdgcn_s_sleep(1); \
    if ((++_sp & 255u) == 0u) { if (xb_ld(&(bar)[XB_TMO])) break; if (_sp > XB_SPIN_CAP) { atomicAdd(&(bar)[XB_TMO], 1u); break; } } } } while (0)

struct XcdBarrier {
    unsigned* bar; unsigned x;
    volatile LAS unsigned* st;
};

__device__ __forceinline__ XcdBarrier xcd_barrier_post(unsigned* bar, volatile LAS unsigned* st) {
    XcdBarrier b; b.bar = bar; b.x = xb_xcc_id(); b.st = st;
    if (threadIdx.x == 0) (void)xb_add(&bar[XB_XCNT(b.x)], 1u);
    return b;
}
__device__ __forceinline__ void xcd_barrier_complete(unsigned* bar, unsigned x, unsigned& nloc, unsigned& nx) {
    const unsigned G = gridDim.x * gridDim.y * gridDim.z;
    unsigned sum, cnt, mine, sp = 0u;
    for (;;) {
        sum = 0u; cnt = 0u; mine = 0u;
#pragma unroll
        for (unsigned j = 0; j < 16; ++j) { const unsigned c = xb_ld(&bar[XB_XCNT(j)]); sum += c; cnt += (c > 0u) ? 1u : 0u; mine = (j == x) ? c : mine; }
        if (sum == G) break;
        __builtin_amdgcn_s_sleep(1);
        if ((++sp & 255u) == 0u) { if (xb_ld(&bar[XB_TMO])) break; if (sp > XB_SPIN_CAP) { atomicAdd(&bar[XB_TMO], 1u); break; } }
    }
    nloc = mine > 0u ? mine : 1u; nx = cnt > 0u ? cnt : 1u;
}

__device__ __forceinline__ void xcd_barrier(const XcdBarrier& b, int tid) {
    asm volatile("s_waitcnt vmcnt(0)" ::: "memory");
    __syncthreads();
    if (tid == 0) {
        unsigned* bar = b.bar;
        __builtin_amdgcn_s_waitcnt(0);
        unsigned nloc = b.st[0], nx = b.st[1];
        if (nloc == 0u) { xcd_barrier_complete(bar, b.x, nloc, nx); b.st[0] = nloc; b.st[1] = nx; }
        const unsigned old = xb_add(&bar[XB_XSUB(b.x)], 1u);
        const unsigned gen = old / nloc;
        if (old + 1u == (gen + 1u) * nloc) {
            __builtin_amdgcn_fence(__ATOMIC_RELEASE, "agent");
            asm volatile("s_waitcnt vmcnt(0)" ::: "memory");
            const unsigned og = xb_add(&bar[XB_TOP], 1u);
            const unsigned tg = og / nx;
            if (og + 1u == (tg + 1u) * nx) xb_add(&bar[XB_TOPGEN], 1u);
            else XB_SPIN(xb_ld(&bar[XB_TOPGEN]) == tg, bar);
            __builtin_amdgcn_fence(__ATOMIC_ACQUIRE, "agent");
            xb_add(&bar[XB_XGEN(b.x)], 1u);
            asm volatile("s_waitcnt vmcnt(0)" ::: "memory");
        } else {
            XB_SPIN(xb_ld(&bar[XB_XGEN(b.x)]) == gen, bar);
            __builtin_amdgcn_fence(__ATOMIC_ACQUIRE, "agent");
            asm volatile("s_waitcnt vmcnt(0)" ::: "memory");
        }
    }
    __syncthreads();
}

constexpr int NWAVES = 8, NTHR = NWAVES * 64, GRID = 256;
constexpr int RING_BYTES = 131072;
constexpr int LDS_ROWS = RING_BYTES;
constexpr int LDS_RS = LDS_ROWS + 2048;
constexpr int LDS_MISC = LDS_RS + 2048;
constexpr int LDS_AP2 = LDS_MISC + 512;
constexpr int LDS_BYTES = 155648;
static_assert(LDS_AP2 + 8 * 2048 + 8 * 256 <= LDS_BYTES, "LDS map");
constexpr int CW_BAR = 4096;
constexpr int CW_PAIR = 16384;
constexpr int NPHASE = 8 * DEPTH + 1;

struct Args { const float* in[22]; float* out; unsigned char* ws; int ph_lo, ph_hi, sub, pad; };
typedef const __attribute__((address_space(4))) Args CArgs;
struct Frame {
    LAS unsigned char* lds; int tid, lane, wave, vcu, gw;
    CArgs* a;
};
#define LDS_WAIT() asm volatile("s_waitcnt lgkmcnt(0)" ::: "memory")

struct WDesc { int mode; const float* src; const float* src2; const float* g; const float* g2; const float* g3; float gscale; bf16* dst; int K; };
__device__ __forceinline__ float wgain(const WDesc& w, int k) {
    switch (w.mode) {
    case WM_IN: case WM_GU: return w.g[k];
    case WM_OUT: return k < 384 ? w.g[k] : (k < 704 ? w.g2[(k - 384) & 63] * w.gscale : w.g3[k - 704]);
    case WM_UP: return k < 192 ? w.g[k] : (k < 320 ? w.g2[k - 192] : 0.f);
    default: return 1.f; }
}
__device__ __forceinline__ void wconv_tile(const WDesc& w, int n0, int k0, LAS unsigned* scr, int lane) {
    LAS float* gs = (LAS float*)(scr + 32 * 65);
    const int n = n0 + lane; const float* colp = nullptr; int ld = 1, klo = 0, khi = 0;
    switch (w.mode) {
    case WM_IN: { const int c = inproj_src(n); if (c >= 0) { colp = w.src + c; } ld = NIN; khi = D; } break;
    case WM_OUT: colp = w.src + n; ld = D; khi = D; break;
    case WM_UP: if (n < 480) { const int h = n / 96, p = n % 96; colp = w.src + h * 96 + (p < 64 ? p : 64 + perm32c(p - 64)); ld = 480; khi = 192; }
                else if (n >= UCOL_KV && n < UCOL_KV + 640) { colp = w.src2 + (n - UCOL_KV); ld = 640; klo = 192; khi = 320; } break;
    case WM_GU: { const int t = n >> 8, r = n & 255; colp = (r < 128 ? w.src : w.src2) + 128 * t + (r & 127); ld = FF; khi = D; } break;
    default: colp = w.src + n; ld = D; khi = FF; break; }
    const bool ok = colp != nullptr && k0 >= klo && k0 < khi;
    const float* p = ok ? colp + (size_t)(k0 - klo) * ld : w.src; if (!ok) ld = 1;
    gs[lane] = wgain(w, k0 + lane);
    LDS_WAIT(); asm volatile("" ::: "memory");
    const float msk = ok ? 1.f : 0.f;
#pragma unroll
    for (int kb = 0; kb < 64; kb += 16) { float v[16];
#pragma unroll
        for (int i = 0; i < 16; ++i) v[i] = p[(size_t)(kb + i) * ld];
#pragma unroll
        for (int i = 0; i < 16; i += 2) scr[((kb + i) >> 1) * 65 + lane] = pk2(v[i] * gs[kb + i] * msk, v[i + 1] * gs[kb + i + 1] * msk); }
    LDS_WAIT(); asm volatile("" ::: "memory");
    const int c = lane & 7;
#pragma unroll
    for (int j = 0; j < 8; ++j) { const int nn = (lane >> 3) + 8 * j; u32x4 o; o.x = scr[(4 * c + 0) * 65 + nn]; o.y = scr[(4 * c + 1) * 65 + nn]; o.z = scr[(4 * c + 2) * 65 + nn]; o.w = scr[(4 * c + 3) * 65 + nn];
        *(u32x4*)(w.dst + (size_t)(n0 + nn) * w.K + k0 + 8 * c) = o; }
    LDS_WAIT(); asm volatile("" ::: "memory");
}
__device__ __forceinline__ void ph_wconv(Frame& F, int l) {
    CArgs& A = *F.a; unsigned char* ws = A.ws;
    LAS unsigned* scr = (LAS unsigned*)(F.lds + F.wave * 16384);
    const float lam_init = 0.8f - 0.6f * expf(-0.3f * (float)l);
    constexpr int I_IN = 40 * 16, I_OUT = 16 * 16, I_UP = 20 * 6, I_GU1 = 44 * 16, I_DN1 = 16 * 22, NIT = I_IN + I_OUT + I_UP + NE * (I_GU1 + I_DN1);
    for (int it = F.gw; it < NIT; it += GRID * NWAVES) {
        int r = it; WDesc w; w.src2 = nullptr; w.g = nullptr; w.g2 = nullptr; w.g3 = nullptr; w.gscale = 1.f; int nt;
        if (r < I_IN) { w.mode = WM_IN; w.src = A.in[3] + (size_t)l * D * NIN; w.g = A.in[2] + l * D; w.dst = (bf16*)(ws + WS_WIN); w.K = D; nt = 40; }
        else if ((r -= I_IN) < I_OUT) { w.mode = WM_OUT; w.src = A.in[15] + (size_t)l * D * D; w.g = A.in[13] + l * 384; w.g2 = A.in[8] + l * 64; w.g3 = A.in[14] + l * 320; w.gscale = 1.0f - lam_init; w.dst = (bf16*)(ws + WS_WOUT); w.K = D; nt = 16; }
        else if ((r -= I_OUT) < I_UP) { w.mode = WM_UP; w.src = A.in[10] + (size_t)l * 192 * 480; w.src2 = A.in[12] + (size_t)l * 128 * 640; w.g = A.in[9] + l * 192; w.g2 = A.in[11] + l * 128; w.dst = (bf16*)(ws + WS_WUP); w.K = KUP; nt = 20; }
        else { r -= I_UP; const int e = r / (I_GU1 + I_DN1); r -= e * (I_GU1 + I_DN1);
            if (r < I_GU1) { w.mode = WM_GU; w.src = A.in[18] + ((size_t)l * NE + e) * D * FF; w.src2 = A.in[19] + ((size_t)l * NE + e) * D * FF; w.g = A.in[16] + l * D; w.dst = (bf16*)(ws + WS_WGU) + (size_t)e * NGU * D; w.K = D; nt = 44; }
            else { r -= I_GU1; w.mode = WM_DN; w.src = A.in[20] + ((size_t)l * NE + e) * FF * D; w.dst = (bf16*)(ws + WS_WD) + (size_t)e * D * FF; w.K = FF; nt = 16; } }
        wconv_tile(w, (r % nt) * 64, (r / nt) * 64, scr, F.lane);
    }
}
__device__ __forceinline__ void ph_tab(Frame& F) {
    const int* pos = (const int*)F.a->in[1]; float* tab = (float*)(F.a->ws + WS_TAB);
    for (int i = blockIdx.x * NTHR + F.tid; i < M * 28; i += GRID * NTHR) {
        const int t = i / 28, f = i % 28; const float p = (float)pos[t]; float inv; int co, so;
        if (f < 8) { inv = 1.0f / powf(500000.0f, (float)(2 * f) / 16.0f); co = f; so = 8 + f; }
        else if (f < 12) { const int j = f - 8; inv = 1.0f / powf(500000.0f, (float)(2 * j) / 8.0f); co = 16 + j; so = 20 + j; }
        else { const int j = f - 12; inv = 1.0f / powf(10000.0f, (float)(2 * j) / 32.0f); co = 24 + j; so = 40 + j; }
        float s, c; sincosf(p * inv, &s, &c); tab[(size_t)t * TABW + co] = c; tab[(size_t)t * TABW + so] = s; }
}
struct RowGather { u32x4 y[4][2]; float g[4]; int n; };
__device__ __forceinline__ void rg_issue(RowGather& R, unsigned& mask, int selv, int b, const bf16* Y, const float* GATE, int lane) {
    R.n = 0;
#pragma unroll
    for (int k = 0; k < 4; ++k) {
        if (mask != 0u) { const int e = __builtin_ctz(mask); mask &= mask - 1u; const int j = __builtin_amdgcn_readlane(selv, e); const int r = (e * NB + b) * CAP + j;
            R.g[k] = GATE[r]; const u32x4* y = (const u32x4*)(Y + (size_t)r * D) + lane;
#pragma unroll
            for (int q = 0; q < 2; ++q) R.y[k][q] = y[64 * q];
            R.n = k + 1; }
        else { R.g[k] = 0.f;
#pragma unroll
            for (int q = 0; q < 2; ++q) R.y[k][q] = (u32x4){0u, 0u, 0u, 0u}; } }
}
__device__ __forceinline__ void bf8_to_f32(const u32x4 w, f32x4& a, f32x4& b) { a = (f32x4){bf2f(w.x & 0xffffu), bf2f(w.x >> 16), bf2f(w.y & 0xffffu), bf2f(w.y >> 16)}; b = (f32x4){bf2f(w.z & 0xffffu), bf2f(w.z >> 16), bf2f(w.w & 0xffffu), bf2f(w.w >> 16)}; }
__device__ __forceinline__ void rg_add(const RowGather& R, f32x4 (&v)[4]) {
#pragma unroll
    for (int k = 0; k < 4; ++k) { const float g = R.g[k];
#pragma unroll
        for (int q = 0; q < 2; ++q) { f32x4 a, b; bf8_to_f32(R.y[k][q], a, b); v[2 * q] += a * g; v[2 * q + 1] += b * g; } }
}
__device__ __forceinline__ void ph_entry(Frame& F, int mode) {
    CArgs& A = *F.a; unsigned char* ws = A.ws; const float* xin = A.in[0]; bf16* XB = (bf16*)(A.ws + WS_X); float* RSTDA = (float*)(ws + WS_RSTDA);
    const bf16* Y = (const bf16*)(ws + WS_R2); const int* SEL = (const int*)(ws + WS_SEL); const float* GATE = (const float*)(ws + WS_GATE);
    constexpr int STR = GRID * NWAVES;
#pragma unroll 1
    for (int t0 = F.gw; t0 < M; t0 += 2 * STR) {
        const int tt[2] = {t0, t0 + STR};
        f32x4 v[2][4]; int selv[2]; unsigned mask[2] = {0u, 0u}; RowGather R[2];
#pragma unroll
        for (int h = 0; h < 2; ++h) {
            if (mode == 0) { const f32x4* src = (const f32x4*)(xin + (size_t)tt[h] * D) + 2 * F.lane;
#pragma unroll
                for (int j = 0; j < 2; ++j) { v[h][2 * j] = src[128 * j]; v[h][2 * j + 1] = src[128 * j + 1]; } }
            else { selv[h] = SEL[(size_t)tt[h] * NE + (F.lane & 15)]; const u32x4* src = (const u32x4*)(XB + (size_t)tt[h] * D) + F.lane;
#pragma unroll
                for (int j = 0; j < 2; ++j) bf8_to_f32(src[64 * j], v[h][2 * j], v[h][2 * j + 1]); } }
        if (mode != 0) {
#pragma unroll
            for (int h = 0; h < 2; ++h) mask[h] = (unsigned)(__ballot(selv[h] >= 0) & 0xffffull);
#pragma unroll
            for (int h = 0; h < 2; ++h) rg_issue(R[h], mask[h], selv[h], tt[h] / S, Y, GATE, F.lane);
#pragma unroll
            for (int h = 0; h < 2; ++h) rg_add(R[h], v[h]);
            while ((mask[0] | mask[1]) != 0u) {
#pragma unroll
                for (int h = 0; h < 2; ++h) rg_issue(R[h], mask[h], selv[h], tt[h] / S, Y, GATE, F.lane);
#pragma unroll
                for (int h = 0; h < 2; ++h) rg_add(R[h], v[h]); }
        }
#pragma unroll
        for (int h = 0; h < 2; ++h) { const int t = tt[h]; float s = 0.f;
#pragma unroll
            for (int j = 0; j < 4; ++j) s += (v[h][j].x * v[h][j].x + v[h][j].y * v[h][j].y) + (v[h][j].z * v[h][j].z + v[h][j].w * v[h][j].w);
            const float rstd = 1.0f / sqrtf(wave_sum(s) * (1.0f / D) + 1e-6f);
            if (mode == 2) { f32x4* o = (f32x4*)(A.out + (size_t)t * D) + 2 * F.lane; const f32x4* g = (const f32x4*)A.in[21] + 2 * F.lane;
#pragma unroll
                for (int j = 0; j < 2; ++j) { o[128 * j] = v[h][2 * j] * rstd * g[128 * j]; o[128 * j + 1] = v[h][2 * j + 1] * rstd * g[128 * j + 1]; } }
            else { u32x4* o16 = (u32x4*)(XB + (size_t)t * D) + F.lane; if (F.lane == 0) RSTDA[t] = rstd;
#pragma unroll
                for (int j = 0; j < 2; ++j) { u32x4 w; w.x = pk2(v[h][2 * j].x, v[h][2 * j].y); w.y = pk2(v[h][2 * j].z, v[h][2 * j].w); w.z = pk2(v[h][2 * j + 1].x, v[h][2 * j + 1].y); w.w = pk2(v[h][2 * j + 1].z, v[h][2 * j + 1].w); o16[64 * j] = w; } } }
    }
}
__device__ __forceinline__ void ph_router(Frame& F, int l) {
    CArgs& A = *F.a; unsigned char* wsb = A.ws; const bf16* Xp = (const bf16*)(A.ws + WS_X); float* AFF = (float*)(wsb + WS_AFF); float* RSTD = (float*)(wsb + WS_RSTD);
    const float* g = A.in[16] + l * D; const float* wr = A.in[17] + (size_t)l * D * NE;
    LAS float* GW = (LAS float*)F.lds;
    LAS float* XT = (LAS float*)(F.lds + 65536) + F.wave * (16 * 132);
    for (int i = F.tid; i < D * NE / 4; i += NTHR) { const f32x4 w4 = ((const f32x4*)wr)[i]; const float gg = g[i >> 2]; *(LAS f32x4*)(GW + 4 * i) = w4 * gg; }
    __syncthreads();
    const int t0 = F.gw * 16, r = F.lane & 15, q = F.lane >> 4;
    const u32x2* src = (const u32x2*)(Xp + (size_t)(t0 + (F.lane >> 5)) * D) + (F.lane & 31);
    f32x4 acc = (f32x4){0.f, 0.f, 0.f, 0.f}; float ssq = 0.f;
    u32x2 v[8];
#pragma unroll
    for (int i = 0; i < 8; ++i) v[i] = src[(size_t)i * 2 * (D / 4)];
#pragma unroll 1
    for (int c = 0; c < 8; ++c) {
#pragma unroll
        for (int i = 0; i < 8; ++i) *(LAS f32x4*)(XT + (2 * i + (F.lane >> 5)) * 132 + 4 * (F.lane & 31)) = (f32x4){bf2f(v[i].x & 0xffffu), bf2f(v[i].x >> 16), bf2f(v[i].y & 0xffffu), bf2f(v[i].y >> 16)};
        if (c < 7) {
#pragma unroll
            for (int i = 0; i < 8; ++i) v[i] = src[(size_t)i * 2 * (D / 4) + (c + 1) * 32]; }
        LDS_WAIT(); asm volatile("" ::: "memory");
        const LAS float* ap = XT + r * 132 + q; const LAS float* bp = GW + (size_t)(c * 128 + q) * 16 + r;
#pragma unroll
        for (int jj = 0; jj < 32; ++jj) { const float a = ap[4 * jj], b = bp[64 * jj]; ssq += a * a; acc = __builtin_amdgcn_mfma_f32_16x16x4f32(a, b, acc, 0, 0, 0); }
        LDS_WAIT(); asm volatile("" ::: "memory");
    }
    ssq += __shfl_xor(ssq, 16); ssq += __shfl_xor(ssq, 32);
    const float rstd = 1.0f / sqrtf(ssq * (1.0f / D) + 1e-6f);
    if (q == 0) RSTD[t0 + r] = rstd;
    f32x4 aff;
#pragma unroll
    for (int k = 0; k < 4; ++k) { const float rs = __shfl(rstd, 4 * q + k); float lg = acc[k] * rs; float mx = lg;
        mx = fmaxf(mx, __shfl_xor(mx, 1)); mx = fmaxf(mx, __shfl_xor(mx, 2)); mx = fmaxf(mx, __shfl_xor(mx, 4)); mx = fmaxf(mx, __shfl_xor(mx, 8));
        const float ex = expf(lg - mx); float den = ex; den += __shfl_xor(den, 1); den += __shfl_xor(den, 2); den += __shfl_xor(den, 4); den += __shfl_xor(den, 8);
        aff[k] = ex / den; }
    const int b = t0 / S, s0 = t0 % S;
    *(f32x4*)(AFF + ((size_t)b * NE + r) * S + s0 + 4 * q) = aff;
}
__device__ __forceinline__ void topk_select(Frame& F, int b, int e, int half, LAS int* rows) {
    unsigned char* ws = F.a->ws; const float* AFF = (const float*)(ws + WS_AFF); float* GATE = (float*)(ws + WS_GATE); int* SEL = (int*)(ws + WS_SEL); int* IDX = (int*)(ws + WS_IDX);
    LAS unsigned* hist = (LAS unsigned*)F.lds; LAS unsigned* wsum = hist + 256; LAS unsigned* bc = hist + 272;
    unsigned k[8]; { const u32x4* src = (const u32x4*)(AFF + ((size_t)b * NE + e) * S) + 2 * F.tid; const u32x4 a = src[0], c = src[1]; k[0] = a.x; k[1] = a.y; k[2] = a.z; k[3] = a.w; k[4] = c.x; k[5] = c.y; k[6] = c.z; k[7] = c.w; }
    unsigned prefix = 0u, need = CAP;
    for (int pass = 0; pass < 4; ++pass) { const int shift = 24 - 8 * pass;
        if (F.tid < 256) hist[F.tid] = 0u;
        __syncthreads();
#pragma unroll
        for (int i = 0; i < 8; ++i) if (pass == 0 || (k[i] >> (shift + 8)) == prefix) atomicAdd((unsigned*)&hist[(k[i] >> shift) & 255u], 1u);
        __syncthreads();
        if (F.wave == 0) { const unsigned c0 = hist[4 * F.lane], c1 = hist[4 * F.lane + 1], c2 = hist[4 * F.lane + 2], c3 = hist[4 * F.lane + 3]; const unsigned s = c0 + c1 + c2 + c3; unsigned suf = s;
#pragma unroll
            for (int o = 1; o < 64; o <<= 1) { const unsigned t = __shfl_down(suf, o); if (F.lane + o < 64) suf += t; }
            const unsigned above = suf - s;
            if (above < need && need <= suf) { unsigned run = above; int d;
                if (run + c3 >= need) d = 3; else { run += c3; if (run + c2 >= need) d = 2; else { run += c2; if (run + c1 >= need) d = 1; else { run += c1; d = 0; } } }
                bc[0] = (prefix << 8) | (unsigned)(4 * F.lane + d); bc[1] = need - run; } }
        __syncthreads();
        prefix = bc[0]; need = bc[1];
        __syncthreads();
    }
    const unsigned T = prefix;
    unsigned cg = 0u, ce = 0u;
#pragma unroll
    for (int i = 0; i < 8; ++i) { cg += k[i] > T ? 1u : 0u; ce += k[i] == T ? 1u : 0u; }
    unsigned pk = cg | (ce << 16), inc = pk;
#pragma unroll
    for (int o = 1; o < 64; o <<= 1) { const unsigned t = __shfl_up(inc, o); if (F.lane >= o) inc += t; }
    if (F.lane == 63) wsum[F.wave] = inc;
    __syncthreads();
    unsigned base = 0u;
#pragma unroll
    for (int w = 0; w < NWAVES; ++w) base += (w < F.wave) ? wsum[w] : 0u;
    unsigned run = base + inc - pk; unsigned G = run & 0xffffu, E = run >> 16;
#pragma unroll
    for (int i = 0; i < 8; ++i) { const bool gt = k[i] > T, eq = k[i] == T; const bool sel = gt || (eq && E < need); const unsigned slot = G + (E < need ? E : need);
        const int tok = b * S + 8 * F.tid + i;
        if (sel) { rows[slot] = tok; if ((int)(slot >> 8) == half) { const int r = (e * NB + b) * CAP + (int)slot; GATE[r] = __builtin_bit_cast(float, k[i]); IDX[r] = tok; } }
        if (half == 0) SEL[(size_t)tok * NE + e] = sel ? (int)slot : -1;
        G += gt ? 1u : 0u; E += eq ? 1u : 0u; }
    __syncthreads();
}
#ifndef PROBE_DUP
#define PROBE_DUP -1
#endif
#ifndef PROBE_SUB
#define PROBE_SUB 7
#endif
#ifndef PROBE_REPS
#define PROBE_REPS 1
#endif
namespace fa {
typedef float f32x16 __attribute__((ext_vector_type(16)));
typedef short s16x4 __attribute__((ext_vector_type(4)));
typedef short v4i16_t __attribute__((ext_vector_type(4)));
using pg8::bf16x8;
typedef LAS const char* lds_cptr;
constexpr int KOFF = 0, KSLOT_MAX = 12288, VOFF = 4 * KSLOT_MAX, VSLOT = 8192, WSOFF = VOFF + 4 * VSLOT, OSTOFF = WSOFF + 8 * 256, FA_LDS = OSTOFF + 8 * 4096;
static_assert(FA_LDS <= RING_BYTES, "attention LDS");
__device__ __forceinline__ int crow(int r, int hi) { return (r & 3) + 8 * (r >> 2) + 4 * hi; }
typedef float f32x2_t __attribute__((ext_vector_type(2))); typedef __bf16 bf16x2_t __attribute__((ext_vector_type(2)));
__device__ __forceinline__ unsigned cvtpk(float lo, float hi) { const f32x2_t v = {lo, hi}; const bf16x2_t b = __builtin_convertvector(v, bf16x2_t); return __builtin_bit_cast(unsigned, b); }
__device__ __forceinline__ s16x4 vtr(lds_cptr p) { return __builtin_bit_cast(s16x4, __builtin_amdgcn_ds_read_tr16_b64_v4i16((LAS v4i16_t*)p)); }
__device__ __forceinline__ float swap_max(float m) { auto rr = __builtin_amdgcn_permlane32_swap(__float_as_uint(m), __float_as_uint(m), false, false); return __builtin_fmaxf(__uint_as_float(rr[0]), __uint_as_float(rr[1])); }
__device__ __forceinline__ float swap_add(float m) { auto rr = __builtin_amdgcn_permlane32_swap(__float_as_uint(m), __float_as_uint(m), false, false); return __uint_as_float(rr[0]) + __uint_as_float(rr[1]); }
__device__ __forceinline__ void glds16(const void* base, unsigned voff, unsigned lds_dst) { unsigned keep;
    asm volatile("s_mov_b32 %0, m0\n\ts_mov_b32 m0, %3\n\ts_nop 0\n\tglobal_load_lds_dwordx4 %1, %2\n\ts_mov_b32 m0, %0" : "=&s"(keep) : "v"(voff), "s"(base), "s"(lds_dst) : "memory"); }
__device__ __forceinline__ unsigned lds_addr(LAS unsigned char* p) { return (unsigned)__builtin_amdgcn_readfirstlane((int)(unsigned)(size_t)p); }
#define FA_WAITV(N) asm volatile("s_waitcnt vmcnt(%0)" ::"n"(N) : "memory")
#define FA_BAR() asm volatile("s_waitcnt lgkmcnt(0)\n\ts_barrier" ::: "memory")
struct Src { const bf16* q; int ldq; const bf16* k0; int ldk0; const bf16* k1; int ldk1; const bf16* v; int ldv; bf16* o; };
template <int KS> __device__ __forceinline__ void qk_tile(f32x16& p0, f32x16& p1, lds_cptr kp, const bf16x8* qf, const f32x16& init) {
#pragma unroll
    for (int k = 0; k < KS; ++k) { const bf16x8 k0 = *(const LAS bf16x8*)(kp + k * 2048), k1 = *(const LAS bf16x8*)(kp + k * 2048 + 512);
        p0 = __builtin_amdgcn_mfma_f32_32x32x16_bf16(k0, qf[k], k == 0 ? init : p0, 0, 0, 0);
        p1 = __builtin_amdgcn_mfma_f32_32x32x16_bf16(k1, qf[k], k == 0 ? init : p1, 0, 0, 0); }
}
template <bool NEGM> __device__ __forceinline__ void sm_max(f32x16& p0, f32x16& p1, float& mhat, float& lsum, f32x16& o0, f32x16& o1, f32x16& negm, LAS float* wsf, bool first, bool live, int r32, int hi) {
    float ma = __builtin_fmaxf(p0[0], p1[0]), mb = __builtin_fmaxf(p0[1], p1[1]);
#pragma unroll
    for (int r = 2; r < 16; r += 2) { ma = __builtin_fmaxf(ma, __builtin_fmaxf(p0[r], p1[r])); mb = __builtin_fmaxf(mb, __builtin_fmaxf(p0[r + 1], p1[r + 1])); }
    const float rm = swap_max(__builtin_fmaxf(ma, mb));
    if (live && (first || __any(rm > 8.0f))) {
        const float dl = first ? rm : __builtin_fmaxf(rm, 0.f); mhat += dl;
#pragma unroll
        for (int r = 0; r < 16; ++r) { p0[r] -= dl; p1[r] -= dl; if constexpr (NEGM) negm[r] = -mhat; }
        if (!first) { const float f = __builtin_amdgcn_exp2f(-dl); lsum *= f; if (hi == 0) wsf[r32] = f;
#pragma unroll
            for (int r = 0; r < 16; ++r) { const float fr = wsf[crow(r, hi)]; o0[r] *= fr; o1[r] *= fr; } }
    }
}
template <int KS, bool SPLIT>
__device__ __forceinline__ void unit1(const Src& s, int q0, float lam, float eps, LAS unsigned char* lds, int tid) {
    constexpr int NPC = SPLIT ? 8 : 2 * KS, KSLOT = NPC * 1024, OPS = NPC > 8 ? 3 : 2, NT = S / 64, NKF = KS < 3 ? 2 * KS : 6;
    constexpr int NSL = SPLIT ? 8 : 6, LEAD = NSL - 3, KOFF = 0, VOFF = NSL * KSLOT, WSOFF = VOFF + NSL * VSLOT, OSTOFF = VOFF;
    static_assert(WSOFF + 2048 <= LDS_MISC && (!SPLIT || NSL * VSLOT >= 32768), "unit1 LDS");
    const int lane = tid & 63, r32 = lane & 31, hi = lane >> 5, wid = __builtin_amdgcn_readfirstlane(tid >> 6);
    const int grp = SPLIT ? (wid >> 2) : 0, qw = SPLIT ? (wid & 3) : wid;
    const unsigned koffA = (unsigned)(lane * s.ldk0 + wid * 8) * 2u, koffB = (unsigned)(lane * s.ldk1 + (wid & 3) * 8) * 2u;
    const unsigned voff = (unsigned)((16 * (wid & 3) + (lane >> 2)) * s.ldv + (wid >> 2) * 32 + (lane & 3) * 8) * 2u;
#define FA_DMA(t, slot) do { \
        glds16((const char*)s.k0 + (size_t)(t) * 128 * s.ldk0, koffA, lds_addr(lds + KOFF + (slot) * KSLOT + wid * 1024)); \
        if constexpr (NPC > 8) glds16((const char*)s.k1 + (size_t)(t) * 128 * s.ldk1, koffB, lds_addr(lds + KOFF + (slot) * KSLOT + (8 + (wid & 3)) * 1024)); \
        glds16((const char*)s.v + (size_t)(t) * 128 * s.ldv, voff, lds_addr(lds + VOFF + (slot) * VSLOT + wid * 1024)); } while (0)
    LAS float* wsf = (LAS float*)(lds + WSOFF) + wid * 64;
    FA_WAITV(0); FA_BAR();
    _Pragma("unroll") for (int i_ = 0; i_ < NSL - 1; ++i_) FA_DMA(i_, i_);
    bf16x8 qf[KS];
    { const bf16* qrow = s.q + (size_t)(q0 + qw * 32 + r32) * s.ldq + grp * (KS * 16) + hi * 8;
#pragma unroll
      for (int k = 0; k < KS; ++k) qf[k] = *(const bf16x8*)(qrow + 16 * k); }
    float mhat = 0.f, lsum = 0.f; f32x16 o0 = f32x16{}, o1 = f32x16{}, ol = f32x16{}, negm = f32x16{};
    const int kro = hi * 1024 + r32 * 16 + grp * (KS * 2048);
    const int vro = ((lane >> 4) & 1) * 32 + (lane & 3) * 8 + (4 * hi + ((lane & 15) >> 2)) * 64;
    const bf16x8 ones = (bf16x8){0x3F80, 0x3F80, 0x3F80, 0x3F80, 0x3F80, 0x3F80, 0x3F80, 0x3F80};
    f32x16 pA0, pA1, pB0, pB1;
    FA_WAITV((NSL - 3) * OPS); FA_BAR();
    qk_tile<KS>(pA0, pA1, (lds_cptr)(lds + KOFF + kro), qf, negm);
    sm_max<true>(pA0, pA1, mhat, lsum, o0, o1, negm, wsf, true, true, r32, hi);
    bf16x8 kf[NKF];
    { const lds_cptr kpn = (lds_cptr)(lds + KOFF + 1 * KSLOT + kro);
#pragma unroll
      for (int i = 0; i < NKF; ++i) kf[i] = *(const LAS bf16x8*)(kpn + (i >> 1) * 2048 + (i & 1) * 512); }
    int slot = 0;
#define SB() __builtin_amdgcn_sched_barrier(0)
#define EX(x) __builtin_amdgcn_exp2f(x)
#define EXx(P0_, P1_, i) do { f32x16& P_ = (i) < 8 ? P0_ : P1_; constexpr int b_ = (2 * (i)) & 15; P_[b_] = EX(P_[b_]); P_[b_ + 1] = EX(P_[b_ + 1]); } while (0)
#define CVx(P0_, P1_, i) do { f32x16& P_ = (i) < 8 ? P0_ : P1_; constexpr int b_ = (2 * (i)) & 15; pw[(i) >> 2][(i) & 3] = cvtpk(P_[b_], P_[b_ + 1]); } while (0)
#define MX3(d, a, b, c) asm("v_max3_f32 %0, %1, %2, %3" : "=v"(d) : "v"(a), "v"(b), "v"(c))
#define MXp(N0_, N1_, j) do { MX3(ma, ma, N0_[4 * (j)], N1_[4 * (j)]); MX3(mb, mb, N0_[4 * (j) + 1], N1_[4 * (j) + 1]); MX3(ma, ma, N0_[4 * (j) + 2], N1_[4 * (j) + 2]); MX3(mb, mb, N0_[4 * (j) + 3], N1_[4 * (j) + 3]); } while (0)
#define KLD(i, k, h) kf[i] = *(const LAS bf16x8*)(kpn + (k) * 2048 + (h) * 512)
#define KL2(i, k, h) kf[i] = *(const LAS bf16x8*)(kp2 + (k) * 2048 + (h) * 512)
#define VF(i) ((bf16x8){vlo[i][0], vlo[i][1], vlo[i][2], vlo[i][3], vhi[i][0], vhi[i][1], vhi[i][2], vhi[i][3]})
#define PW(k) __builtin_bit_cast(bf16x8, pw[k])
#define MF(A, B, C) __builtin_amdgcn_mfma_f32_32x32x16_bf16(A, B, C, 0, 0, 0)
#define FA_STEP(C0, C1, N0, N1) do { \
        FA_WAITV((NSL - 4) * OPS); FA_BAR(); \
        { const int tn = t + NSL - 1 < NT ? t + NSL - 1 : NT - 1; FA_DMA(tn, slot >= 1 ? slot - 1 : NSL - 1); } \
        const int sn = slot + 1 < NSL ? slot + 1 : 0, sn2 = sn + 1 < NSL ? sn + 1 : 0; const bool live = t + 1 < NT; \
        const lds_cptr kpn = (lds_cptr)(lds + KOFF + sn * KSLOT + kro), kp2 = (lds_cptr)(lds + KOFF + sn2 * KSLOT + kro); const lds_cptr vp = (lds_cptr)(lds + VOFF + slot * VSLOT + vro); \
        s16x4 vlo[8], vhi[8]; u32x4 pw[4]; float ma = -INFINITY, mb = -INFINITY; \
        _Pragma("unroll") for (int i = 0; i < 8; ++i) { vlo[i] = vtr(vp + (i >> 2) * 4096 + (i & 3) * 1024); vhi[i] = vtr(vp + (i >> 2) * 4096 + (i & 3) * 1024 + 512); } \
        SB(); __builtin_amdgcn_s_setprio(1); \
        if constexpr (KS == 2) { \
            EXx(C0, C1, 0); EXx(C0, C1, 1); EXx(C0, C1, 2); CVx(C0, C1, 0); CVx(C0, C1, 1); SB(); \
            N0 = MF(kf[0], qf[0], negm); EXx(C0, C1, 3); CVx(C0, C1, 2); SB(); \
            N1 = MF(kf[1], qf[0], negm); EXx(C0, C1, 4); CVx(C0, C1, 3); SB(); \
            N0 = MF(kf[2], qf[1], N0); EXx(C0, C1, 5); CVx(C0, C1, 4); SB(); \
            N1 = MF(kf[3], qf[1], N1); EXx(C0, C1, 6); CVx(C0, C1, 5); SB(); \
            o0 = MF(PW(0), VF(0), o0); EXx(C0, C1, 7); CVx(C0, C1, 6); SB(); \
            o1 = MF(PW(0), VF(4), o1); EXx(C0, C1, 8); CVx(C0, C1, 7); SB(); \
            ol = MF(PW(0), ones, ol); KL2(0, 0, 0); KL2(1, 0, 1); EXx(C0, C1, 9); CVx(C0, C1, 8); SB(); \
            o0 = MF(PW(1), VF(1), o0); KL2(2, 1, 0); KL2(3, 1, 1); EXx(C0, C1, 10); CVx(C0, C1, 9); SB(); \
            o1 = MF(PW(1), VF(5), o1); EXx(C0, C1, 11); CVx(C0, C1, 10); SB(); \
            ol = MF(PW(1), ones, ol); EXx(C0, C1, 12); CVx(C0, C1, 11); SB(); \
            o0 = MF(PW(2), VF(2), o0); EXx(C0, C1, 13); CVx(C0, C1, 12); SB(); \
            o1 = MF(PW(2), VF(6), o1); EXx(C0, C1, 14); CVx(C0, C1, 13); SB(); \
            ol = MF(PW(2), ones, ol); EXx(C0, C1, 15); CVx(C0, C1, 14); CVx(C0, C1, 15); SB(); \
            o0 = MF(PW(3), VF(3), o0); MXp(N0, N1, 0); SB(); \
            o1 = MF(PW(3), VF(7), o1); MXp(N0, N1, 1); SB(); \
            ol = MF(PW(3), ones, ol); MXp(N0, N1, 2); MXp(N0, N1, 3); SB(); \
        } else { \
            EXx(C0, C1, 0); EXx(C0, C1, 1); CVx(C0, C1, 0); SB(); \
            N0 = MF(kf[0], qf[0], negm); EXx(C0, C1, 2); CVx(C0, C1, 1); SB(); \
            N1 = MF(kf[1], qf[0], negm); KLD(0, 3, 0); KLD(1, 3, 1); EXx(C0, C1, 3); CVx(C0, C1, 2); SB(); \
            N0 = MF(kf[2], qf[1], N0); EXx(C0, C1, 4); CVx(C0, C1, 3); SB(); \
            N1 = MF(kf[3], qf[1], N1); KLD(2, 4, 0); KLD(3, 4, 1); EXx(C0, C1, 5); CVx(C0, C1, 4); SB(); \
            N0 = MF(kf[4], qf[2], N0); EXx(C0, C1, 6); CVx(C0, C1, 5); SB(); \
            N1 = MF(kf[5], qf[2], N1); KLD(4, 5, 0); KLD(5, 5, 1); EXx(C0, C1, 7); CVx(C0, C1, 6); SB(); \
            N0 = MF(kf[0], qf[3], N0); EXx(C0, C1, 8); CVx(C0, C1, 7); SB(); \
            N1 = MF(kf[1], qf[3], N1); EXx(C0, C1, 9); CVx(C0, C1, 8); SB(); \
            N0 = MF(kf[2], qf[4], N0); EXx(C0, C1, 10); CVx(C0, C1, 9); SB(); \
            N1 = MF(kf[3], qf[4], N1); EXx(C0, C1, 11); CVx(C0, C1, 10); SB(); \
            N0 = MF(kf[4], qf[5], N0); EXx(C0, C1, 12); CVx(C0, C1, 11); SB(); \
            N1 = MF(kf[5], qf[5], N1); EXx(C0, C1, 13); CVx(C0, C1, 12); SB(); \
            o0 = MF(PW(0), VF(0), o0); EXx(C0, C1, 14); CVx(C0, C1, 13); SB(); \
            o1 = MF(PW(0), VF(4), o1); EXx(C0, C1, 15); CVx(C0, C1, 14); SB(); \
            ol = MF(PW(0), ones, ol); CVx(C0, C1, 15); SB(); \
            o0 = MF(PW(1), VF(1), o0); KL2(0, 0, 0); KL2(1, 0, 1);  SB(); \
            o1 = MF(PW(1), VF(5), o1); KL2(2, 1, 0); KL2(3, 1, 1);  SB(); \
            ol = MF(PW(1), ones, ol); KL2(4, 2, 0); KL2(5, 2, 1);  SB(); \
            o0 = MF(PW(2), VF(2), o0); MXp(N0, N1, 0); SB(); \
            o1 = MF(PW(2), VF(6), o1); MXp(N0, N1, 1); SB(); \
            ol = MF(PW(2), ones, ol); MXp(N0, N1, 2); SB(); \
            o0 = MF(PW(3), VF(3), o0); MXp(N0, N1, 3); SB(); \
            o1 = MF(PW(3), VF(7), o1);  SB(); \
            ol = MF(PW(3), ones, ol);  SB(); \
        } \
        __builtin_amdgcn_s_setprio(0); \
          \
        { const float rm = swap_max(__builtin_fmaxf(ma, mb)); \
          if (live && __any(rm > 8.0f)) { \
              const float dl = __builtin_fmaxf(rm, 0.f); mhat += dl; \
              _Pragma("unroll") for (int r = 0; r < 16; ++r) { N0[r] -= dl; N1[r] -= dl; negm[r] = -mhat; } \
              const float f = __builtin_amdgcn_exp2f(-dl); if (hi == 0) wsf[r32] = f; \
              _Pragma("unroll") for (int r = 0; r < 16; ++r) { const float fr = wsf[crow(r, hi)]; o0[r] *= fr; o1[r] *= fr; ol[r] *= fr; } } } \
        slot = sn; } while (0)
    static_assert(KS == 2 || KS == 6, "unit1: schedules exist for KS = 2 and KS = 6");
#pragma unroll 1
    for (int t = 0; t < NT; t += 2) {
        FA_STEP(pA0, pA1, pB0, pB1);
        ++t; FA_STEP(pB0, pB1, pA0, pA1); --t;
    }
#undef FA_STEP
#undef SB
#undef EX
#undef EXx
#undef CVx
#undef MXp
#undef MX3
#undef KLD
#undef KL2
#undef VF
#undef PW
#undef MF
    f32x16 out[2];
#pragma unroll
    for (int r = 0; r < 16; ++r) { const float il = 1.0f / ol[r]; out[0][r] = o0[r] * il; out[1][r] = o1[r] * il; }
    FA_WAITV(0); FA_BAR();
    if constexpr (SPLIT) {
        LAS float* xch = (LAS float*)(lds + OSTOFF) + (size_t)qw * 2048;
        if (grp == 1) {
#pragma unroll
            for (int r = 0; r < 16; ++r) { xch[r * 64 + lane] = lam * out[0][r]; xch[(16 + r) * 64 + lane] = lam * out[1][r]; } }
        FA_BAR();
        if (grp == 1) return;
#pragma unroll
        for (int r = 0; r < 16; ++r) { out[0][r] -= xch[r * 64 + lane]; out[1][r] -= xch[(16 + r) * 64 + lane]; }
    }
    bf16* Ow = s.o + (size_t)(q0 + qw * 32) * D;
    LAS bf16* stg = (LAS bf16*)(lds + KOFF) + qw * 2048;
#pragma unroll
    for (int r = 0; r < 16; ++r) { float ss = out[0][r] * out[0][r] + out[1][r] * out[1][r];
        ss += __shfl_xor(ss, 1); ss += __shfl_xor(ss, 2); ss += __shfl_xor(ss, 4); ss += __shfl_xor(ss, 8); ss += __shfl_xor(ss, 16);
        const float rstd = 1.0f / sqrtf(ss * (1.0f / 64.0f) + eps); const int orow = crow(r, hi);
        stg[orow * 64 + r32] = (bf16)f2bf(out[0][r] * rstd); stg[orow * 64 + 32 + r32] = (bf16)f2bf(out[1][r] * rstd); }
#pragma unroll
    for (int i = 0; i < 4; ++i) { const int row = i * 8 + (lane >> 3), ch = lane & 7; const u32x4 v = *(const LAS u32x4*)(stg + row * 64 + ch * 8); *(u32x4*)(Ow + (size_t)row * D + ch * 8) = v; }
#undef FA_DMA
}
}

__device__ __forceinline__ void ph_attn_bc(Frame& F, int l) {
    unsigned char* ws = F.a->ws; const bf16* P = (const bf16*)(ws + WS_R1); const bf16* U = (const bf16*)(ws + WS_R2); bf16* O = (bf16*)(ws + WS_O);
    const float *lq1 = F.a->in[4] + l * 32, *lk1 = F.a->in[5] + l * 32, *lq2 = F.a->in[6] + l * 32, *lk2 = F.a->in[7] + l * 32;
    float d1 = 0.f, d2 = 0.f; for (int j = 0; j < 32; ++j) { d1 += lq1[j] * lk1[j]; d2 += lq2[j] * lk2[j]; }
    const float lam = expf(d1) - expf(d2) + (0.8f - 0.6f * expf(-0.3f * (float)l));
    if (F.a->sub & 2) {
    { const int xg = F.vcu >> 5, w = F.vcu & 31; const int nb = w < 16 ? 8 : 2, k0 = w < 16 ? w : 128 + (w - 16);
#pragma unroll 1
    for (int i = 0; i < nb; ++i) { const int k = k0 + 16 * i, bh = xg + 8 * (k >> 5), qb = k & 31, b = bh / 5, h = bh % 5; const bf16* pb = P + (size_t)b * S * NINP;
        fa::Src sr{pb + COL_BQ + h * 64, NINP, pb + COL_BK + h * 64, NINP, pb + COL_BK + h * 64, NINP, pb + COL_BV + h * 64, NINP, O + (size_t)b * S * D + 384 + h * 64};
        fa::unit1<2, true>(sr, qb * 128, lam, 1e-5f, F.lds, F.tid); } }
    }
    asm volatile("s_waitcnt vmcnt(0) lgkmcnt(0)\n\ts_barrier" ::: "memory");
    if (F.a->sub & 4) { const int xg = F.vcu >> 5, w = F.vcu & 31; const int nc = w < 16 ? 0 : 5, k0 = w < 16 ? 0 : (w - 16);
#pragma unroll 1
    for (int i = 0; i < nc; ++i) { const int k = k0 + 16 * i, bh = xg + 8 * (k >> 4), qb = k & 15, b = bh / 5, h = bh % 5; const bf16* ub = U + (size_t)b * S * NUP;
        fa::Src sr{ub + h * 96, NUP, ub + UCOL_KV + h * 128, NUP, P + (size_t)b * S * NINP + COL_CKR, NINP, ub + UCOL_KV + h * 128 + 64, NUP, O + (size_t)b * S * D + 704 + h * 64};
        fa::unit1<6, false>(sr, qb * 256, 0.f, 1e-6f, F.lds, F.tid); } }
    asm volatile("s_waitcnt vmcnt(0) lgkmcnt(0)\n\ts_barrier" ::: "memory");
}
namespace fa {
constexpr int AK_CH = 384 * 16, AV_DH = 384 * 64, AKOFF = 0, AVOFF = 8 * AK_CH, AWSOFF = AVOFF + 2 * AV_DH, ASTOFF = AWSOFF + 2048;
static_assert(ASTOFF + 8 * 4096 <= LDS_MISC, "A-pattern LDS");
struct AUnit { const bf16* Pb; int h, sh, c, U0, L; size_t rowbase; };
__device__ __forceinline__ AUnit aunit_decode(const bf16* P, int u) { const int bh = u / 48, rem = u % 48, pat = rem >> 4, blk = rem & 15, b = bh / 6, bpc = 16 >> (2 * pat);
    AUnit a; a.Pb = P + (size_t)b * S * NINP; a.h = bh % 6; a.sh = 2 * pat; a.c = blk / bpc; a.U0 = (blk % bpc) * 256; a.L = S >> a.sh; a.rowbase = (size_t)pat * M + (size_t)b * S; return a; }
__device__ __forceinline__ void aunit_dma(const AUnit& a, LAS unsigned char* lds, int wid, int lane) {
#pragma unroll
    for (int j = 0; j < 6; ++j) { const int pid = wid + 8 * j, ch = pid / 6, rg = pid % 6; int u = a.U0 - 64 + 64 * rg + lane; u = u < 0 ? 0 : (u >= a.L ? a.L - 1 : u);
        glds16(a.Pb, (unsigned)((a.c + (u << a.sh)) * NINP + COL_AK + a.h * 64 + ch * 8) * 2u, lds_addr(lds + AKOFF + ch * AK_CH + rg * 1024)); }
#pragma unroll
    for (int j = 0; j < 6; ++j) { const int pid = wid + 8 * j, dh = pid / 24, rg = pid % 24; int u = a.U0 - 64 + 16 * rg + (lane >> 2); u = u < 0 ? 0 : (u >= a.L ? a.L - 1 : u);
        glds16(a.Pb, (unsigned)((a.c + (u << a.sh)) * NINP + COL_AV + a.h * 64 + dh * 32 + (lane & 3) * 8) * 2u, lds_addr(lds + AVOFF + dh * AV_DH + rg * 1024)); }
}
}
__device__ __forceinline__ void ph_apat(Frame& F) {
    using namespace fa;
    unsigned char* ws = F.a->ws; const bf16* P = (const bf16*)(ws + WS_R1); bf16* PO = (bf16*)(ws + WS_AP); float* PM = (float*)(ws + WS_AP + AP_PO_BYTES); float* PL = (float*)(ws + WS_AP + AP_PO_BYTES + AP_ML_BYTES);
    LAS unsigned char* lds = F.lds; const int tid = F.tid, lane = tid & 63, r32 = lane & 31, hi = lane >> 5, wid = __builtin_amdgcn_readfirstlane(tid >> 6);
    const int e = F.vcu >> 1, u0 = e * 18 + ((F.vcu & 1) ? 8 : 0), n = (F.vcu & 1) ? 10 : 8;
    LAS float* wsf = (LAS float*)(lds + AWSOFF) + wid * 64; LAS bf16* stg = (LAS bf16*)(lds + ASTOFF) + wid * 2048;
    const int vro = ((lane >> 4) & 1) * 32 + (lane & 3) * 8 + (4 * hi + ((lane & 15) >> 2)) * 64;
    const bf16x8 ones = (bf16x8){0x3F80, 0x3F80, 0x3F80, 0x3F80, 0x3F80, 0x3F80, 0x3F80, 0x3F80};
    FA_WAITV(0); FA_BAR();
    AUnit a = aunit_decode(P, u0); aunit_dma(a, lds, wid, lane);
    AUnit prev = a; int prev_uq = 0; float pm_keep = 0.f; f32x16 pl_keep = f32x16{};
#define APAT_FLUSH() do { \
        if (hi == 0) PM[(prev.rowbase + (size_t)(prev.c + (prev_uq << prev.sh))) * 6 + prev.h] = pm_keep; \
        if (r32 == 0) { _Pragma("unroll") for (int r = 0; r < 16; ++r) PL[(prev.rowbase + (size_t)(prev.c + ((prev.U0 + 32 * wid + crow(r, hi)) << prev.sh))) * 6 + prev.h] = pl_keep[r]; } \
        _Pragma("unroll") for (int q = 0; q < 4; ++q) { const int row = q * 8 + (lane >> 3), ch = lane & 7; const u32x4 v = *(const LAS u32x4*)(stg + row * 64 + ch * 8); \
            const size_t t = prev.rowbase + (size_t)(prev.c + ((prev.U0 + 32 * wid + row) << prev.sh)); *(u32x4*)(PO + (t * 6 + prev.h) * 64 + ch * 8) = v; } } while (0)
    bf16x8 qf[4];
    { const bf16* qrow = a.Pb + (size_t)(a.c + ((a.U0 + 32 * wid + r32) << a.sh)) * NINP + COL_AQ + a.h * 64 + hi * 8;
#pragma unroll
      for (int k = 0; k < 4; ++k) qf[k] = *(const bf16x8*)(qrow + 16 * k); }
#pragma unroll 1
    for (int i = 0; i < n; ++i) {
        FA_WAITV(0); FA_BAR();
        if (i > 0) APAT_FLUSH();
        const int uq = a.U0 + 32 * wid + r32, L = a.L;
        float m = -1e30f; f32x16 o0 = f32x16{}, o1 = f32x16{}, ol = f32x16{};
#pragma unroll
        for (int j = 0; j < 3; ++j) {
            const int st0 = wid + 2 * j, st1 = st0 + 1;
            const lds_cptr kp0 = (lds_cptr)(lds + AKOFF + hi * AK_CH + (32 * st0 + r32) * 16), kp1 = kp0 + 512;
            f32x16 p0 = f32x16{}, p1 = f32x16{};
#pragma unroll
            for (int k = 0; k < 4; ++k) { p0 = __builtin_amdgcn_mfma_f32_32x32x16_bf16(*(const LAS bf16x8*)(kp0 + 2 * k * AK_CH), qf[k], p0, 0, 0, 0);
                if (j < 2) p1 = __builtin_amdgcn_mfma_f32_32x32x16_bf16(*(const LAS bf16x8*)(kp1 + 2 * k * AK_CH), qf[k], p1, 0, 0, 0); }
            float rm = -INFINITY;
#pragma unroll
            for (int r = 0; r < 16; ++r) { const int d0 = 64 * j - 64 + crow(r, hi) - r32, k0 = uq + d0; const bool ok0 = d0 >= -64 && d0 <= 64 && k0 >= 0 && k0 < L; p0[r] = ok0 ? p0[r] : -INFINITY; rm = __builtin_fmaxf(rm, p0[r]);
                if (j < 2) { const int d1 = d0 + 32, k1 = uq + d1; const bool ok1 = d1 >= -64 && d1 <= 64 && k1 >= 0 && k1 < L; p1[r] = ok1 ? p1[r] : -INFINITY; rm = __builtin_fmaxf(rm, p1[r]); } }
            rm = swap_max(rm);
            if (__any(rm > m + 8.0f)) {
                const float mn = __builtin_fmaxf(m, rm), f = __builtin_amdgcn_exp2f(m - mn); m = mn; if (hi == 0) wsf[r32] = f;
#pragma unroll
                for (int r = 0; r < 16; ++r) { const float fr = wsf[crow(r, hi)]; o0[r] *= fr; o1[r] *= fr; ol[r] *= fr; } }
            u32x4 pw[4];
#pragma unroll
            for (int q = 0; q < 4; ++q) { pw[0][q] = cvtpk(__builtin_amdgcn_exp2f(p0[2 * q] - m), __builtin_amdgcn_exp2f(p0[2 * q + 1] - m)); pw[1][q] = cvtpk(__builtin_amdgcn_exp2f(p0[8 + 2 * q] - m), __builtin_amdgcn_exp2f(p0[9 + 2 * q] - m));
                if (j < 2) { pw[2][q] = cvtpk(__builtin_amdgcn_exp2f(p1[2 * q] - m), __builtin_amdgcn_exp2f(p1[2 * q + 1] - m)); pw[3][q] = cvtpk(__builtin_amdgcn_exp2f(p1[8 + 2 * q] - m), __builtin_amdgcn_exp2f(p1[9 + 2 * q] - m)); } }
            const lds_cptr vp = (lds_cptr)(lds + AVOFF + 32 * st0 * 64 + vro);
#pragma unroll
            for (int kk = 0; kk < (j < 2 ? 4 : 2); ++kk) { const bf16x8 pa = __builtin_bit_cast(bf16x8, pw[kk]);
                const s16x4 l0 = vtr(vp + kk * 1024), h0 = vtr(vp + kk * 1024 + 512), l1 = vtr(vp + AV_DH + kk * 1024), h1 = vtr(vp + AV_DH + kk * 1024 + 512);
                o0 = __builtin_amdgcn_mfma_f32_32x32x16_bf16(pa, (bf16x8){l0[0], l0[1], l0[2], l0[3], h0[0], h0[1], h0[2], h0[3]}, o0, 0, 0, 0);
                o1 = __builtin_amdgcn_mfma_f32_32x32x16_bf16(pa, (bf16x8){l1[0], l1[1], l1[2], l1[3], h1[0], h1[1], h1[2], h1[3]}, o1, 0, 0, 0);
                ol = __builtin_amdgcn_mfma_f32_32x32x16_bf16(pa, ones, ol, 0, 0, 0); }
        }
        FA_BAR();
        const AUnit cur = a;
        if (i + 1 < n) { a = aunit_decode(P, u0 + i + 1); aunit_dma(a, lds, wid, lane); }
        pm_keep = m; pl_keep = ol; prev = cur; prev_uq = uq;
#pragma unroll
        for (int r = 0; r < 16; ++r) { const float il = 1.0f / ol[r]; const int orow = crow(r, hi);
            stg[orow * 64 + r32] = (bf16)f2bf(o0[r] * il); stg[orow * 64 + 32 + r32] = (bf16)f2bf(o1[r] * il); }
        if (i + 1 < n) { const bf16* qrow = a.Pb + (size_t)(a.c + ((a.U0 + 32 * wid + r32) << a.sh)) * NINP + COL_AQ + a.h * 64 + hi * 8;
#pragma unroll
            for (int k = 0; k < 4; ++k) qf[k] = *(const bf16x8*)(qrow + 16 * k); }
    }
    APAT_FLUSH();
#undef APAT_FLUSH
    asm volatile("s_waitcnt vmcnt(0) lgkmcnt(0)\n\ts_barrier" ::: "memory");
}
namespace fa {
constexpr int A2K_CH = 256 * 16, A2V_DH = 256 * 64, A2HALF = 65536;
__device__ __forceinline__ AUnit aunit2_decode(const bf16* P, int u) { const int bh = u / 96, rem = u % 96, pat = rem >> 5, blk = rem & 31, b = bh / 6, bpc = 32 >> (2 * pat);
    AUnit a; a.Pb = P + (size_t)b * S * NINP; a.h = bh % 6; a.sh = 2 * pat; a.c = blk / bpc; a.U0 = (blk % bpc) * 128; a.L = S >> a.sh; a.rowbase = (size_t)pat * M + (size_t)b * S; return a; }
__device__ __forceinline__ void aunit2_dma(const AUnit& a, LAS unsigned char* hb, int w4, int lane) {
#pragma unroll
    for (int j = 0; j < 8; ++j) { const int pid = w4 + 4 * j, ch = pid >> 2, rg = pid & 3; int u = a.U0 - 64 + 64 * rg + lane; u = u < 0 ? 0 : (u >= a.L ? a.L - 1 : u);
        glds16(a.Pb, (unsigned)((a.c + (u << a.sh)) * NINP + COL_AK + a.h * 64 + ch * 8) * 2u, lds_addr(hb + ch * A2K_CH + rg * 1024)); }
#pragma unroll
    for (int j = 0; j < 8; ++j) { const int pid = w4 + 4 * j, dh = pid >> 4, rg = pid & 15; int u = a.U0 - 64 + 16 * rg + (lane >> 2); u = u < 0 ? 0 : (u >= a.L ? a.L - 1 : u);
        glds16(a.Pb, (unsigned)((a.c + (u << a.sh)) * NINP + COL_AV + a.h * 64 + dh * 32 + (lane & 3) * 8) * 2u, lds_addr(hb + 32768 + dh * A2V_DH + rg * 1024)); }
}
__device__ __forceinline__ void half_bar(volatile LAS unsigned* cnt, unsigned& gen, int lane) {
    asm volatile("s_waitcnt lgkmcnt(0)" ::: "memory"); ++gen;
    if (lane == 0) __hip_atomic_fetch_add((LAS unsigned*)cnt, 1u, __ATOMIC_RELAXED, __HIP_MEMORY_SCOPE_WORKGROUP);
    for (unsigned sp = 0; *cnt < 4u * gen; ++sp) { __builtin_amdgcn_s_sleep(1); if (sp > (1u << 22)) break; }
    asm volatile("" ::: "memory");
}
}
__device__ __forceinline__ void ph_apat2(Frame& F, volatile LAS unsigned* MISC) {
    using namespace fa;
    unsigned char* ws = F.a->ws; const bf16* P = (const bf16*)(ws + WS_R1); bf16* PO = (bf16*)(ws + WS_AP); float* PM = (float*)(ws + WS_AP + AP_PO_BYTES); float* PL = (float*)(ws + WS_AP + AP_PO_BYTES + AP_ML_BYTES);
    const int tid = F.tid, lane = tid & 63, r32 = lane & 31, hi = lane >> 5, wid = __builtin_amdgcn_readfirstlane(tid >> 6), half = wid >> 2, w4 = wid & 3;
    LAS unsigned char* hb = F.lds + half * A2HALF;
    LAS float* wsf = (LAS float*)(F.lds + LDS_AP2 + 8 * 2048) + wid * 64; LAS bf16* stg = (LAS bf16*)(F.lds + LDS_AP2) + wid * 1024;
    volatile LAS unsigned* cnt = MISC + 8 + half; unsigned gen = 0u;
    const int e = F.vcu >> 1, odd = F.vcu & 1, n = odd ? 10 : 8, u0 = e * 36 + (odd ? 16 + 10 * half : 8 * half);
    const int vro = ((lane >> 4) & 1) * 32 + (lane & 3) * 8 + (4 * hi + ((lane & 15) >> 2)) * 64;
    const bf16x8 ones = (bf16x8){0x3F80, 0x3F80, 0x3F80, 0x3F80, 0x3F80, 0x3F80, 0x3F80, 0x3F80};
    if (tid == 0) { MISC[8] = 0u; MISC[9] = 0u; }
    asm volatile("s_waitcnt vmcnt(0) lgkmcnt(0)\n\ts_barrier" ::: "memory");
    AUnit a = aunit2_decode(P, u0); aunit2_dma(a, hb, w4, lane);
    bf16x8 qf[4];
    { const bf16* qrow = a.Pb + (size_t)(a.c + ((a.U0 + 32 * w4 + r32) << a.sh)) * NINP + COL_AQ + a.h * 64 + hi * 8;
#pragma unroll
      for (int k = 0; k < 4; ++k) qf[k] = *(const bf16x8*)(qrow + 16 * k); }
#pragma unroll 1
    for (int i = 0; i < n; ++i) {
        FA_WAITV(0); half_bar(cnt, gen, lane);
        const int uq = a.U0 + 32 * w4 + r32, L = a.L; const bool edge = a.U0 < 64 || a.U0 + 192 > L;
        float m = -1e30f; f32x16 o0 = f32x16{}, o1 = f32x16{}, ol = f32x16{};
#pragma unroll
        for (int j = 0; j < 3; ++j) {
            const int st0 = w4 + 2 * j;
            const lds_cptr kp0 = (lds_cptr)(hb + hi * A2K_CH + (32 * st0 + r32) * 16), kp1 = kp0 + 512;
            f32x16 p0 = f32x16{}, p1 = f32x16{};
#pragma unroll
            for (int k = 0; k < 4; ++k) { p0 = __builtin_amdgcn_mfma_f32_32x32x16_bf16(*(const LAS bf16x8*)(kp0 + 2 * k * A2K_CH), qf[k], p0, 0, 0, 0);
                if (j < 2) p1 = __builtin_amdgcn_mfma_f32_32x32x16_bf16(*(const LAS bf16x8*)(kp1 + 2 * k * A2K_CH), qf[k], p1, 0, 0, 0); }
            float rm = -INFINITY;
            if (edge) {
#pragma unroll
                for (int r = 0; r < 16; ++r) { const int d0 = 64 * j - 64 + crow(r, hi) - r32, k0 = uq + d0; const bool ok0 = d0 >= -64 && d0 <= 64 && k0 >= 0 && k0 < L; p0[r] = ok0 ? p0[r] : -INFINITY; rm = __builtin_fmaxf(rm, p0[r]);
                    if (j < 2) { const int d1 = d0 + 32, k1 = uq + d1; const bool ok1 = d1 >= -64 && d1 <= 64 && k1 >= 0 && k1 < L; p1[r] = ok1 ? p1[r] : -INFINITY; rm = __builtin_fmaxf(rm, p1[r]); } }
            } else {
#pragma unroll
                for (int r = 0; r < 16; ++r) { if (j == 0) p0[r] = crow(r, hi) >= r32 ? p0[r] : -INFINITY; if (j == 2) p0[r] = crow(r, hi) <= r32 ? p0[r] : -INFINITY;
                    rm = __builtin_fmaxf(rm, p0[r]); if (j < 2) rm = __builtin_fmaxf(rm, p1[r]); }
            }
            rm = swap_max(rm);
            if (__any(rm > m + 8.0f)) {
                const float mn = __builtin_fmaxf(m, rm), f = __builtin_amdgcn_exp2f(m - mn); m = mn; if (hi == 0) wsf[r32] = f;
#pragma unroll
                for (int r = 0; r < 16; ++r) { const float fr = wsf[crow(r, hi)]; o0[r] *= fr; o1[r] *= fr; ol[r] *= fr; } }
            u32x4 pw[4];
#pragma unroll
            for (int q = 0; q < 4; ++q) { pw[0][q] = cvtpk(__builtin_amdgcn_exp2f(p0[2 * q] - m), __builtin_amdgcn_exp2f(p0[2 * q + 1] - m)); pw[1][q] = cvtpk(__builtin_amdgcn_exp2f(p0[8 + 2 * q] - m), __builtin_amdgcn_exp2f(p0[9 + 2 * q] - m));
                if (j < 2) { pw[2][q] = cvtpk(__builtin_amdgcn_exp2f(p1[2 * q] - m), __builtin_amdgcn_exp2f(p1[2 * q + 1] - m)); pw[3][q] = cvtpk(__builtin_amdgcn_exp2f(p1[8 + 2 * q] - m), __builtin_amdgcn_exp2f(p1[9 + 2 * q] - m)); } }
            const lds_cptr vp = (lds_cptr)(hb + 32768 + 32 * st0 * 64 + vro);
#pragma unroll
            for (int kk = 0; kk < (j < 2 ? 4 : 2); ++kk) { const bf16x8 pa = __builtin_bit_cast(bf16x8, pw[kk]);
                const s16x4 l0 = vtr(vp + kk * 1024), h0 = vtr(vp + kk * 1024 + 512), l1 = vtr(vp + A2V_DH + kk * 1024), h1 = vtr(vp + A2V_DH + kk * 1024 + 512);
                o0 = __builtin_amdgcn_mfma_f32_32x32x16_bf16(pa, (bf16x8){l0[0], l0[1], l0[2], l0[3], h0[0], h0[1], h0[2], h0[3]}, o0, 0, 0, 0);
                o1 = __builtin_amdgcn_mfma_f32_32x32x16_bf16(pa, (bf16x8){l1[0], l1[1], l1[2], l1[3], h1[0], h1[1], h1[2], h1[3]}, o1, 0, 0, 0);
                ol = __builtin_amdgcn_mfma_f32_32x32x16_bf16(pa, ones, ol, 0, 0, 0); }
        }
        half_bar(cnt, gen, lane);
        const AUnit cur = a;
        if (i + 1 < n) { a = aunit2_decode(P, u0 + i + 1); aunit2_dma(a, hb, w4, lane); }
        if (hi == 0) PM[(cur.rowbase + (size_t)(cur.c + (uq << cur.sh))) * 6 + cur.h] = m;
        if (r32 == 0) {
#pragma unroll
            for (int r = 0; r < 16; ++r) PL[(cur.rowbase + (size_t)(cur.c + ((cur.U0 + 32 * w4 + crow(r, hi)) << cur.sh))) * 6 + cur.h] = ol[r]; }
#pragma unroll
        for (int ps = 0; ps < 2; ++ps) {
#pragma unroll
            for (int r = 0; r < 16; ++r) if ((crow(r, 0) >> 4) == ps) { const float il = 1.0f / ol[r]; const int orow = crow(r, hi) & 15;
                stg[orow * 64 + r32] = (bf16)f2bf(o0[r] * il); stg[orow * 64 + 32 + r32] = (bf16)f2bf(o1[r] * il); }
#pragma unroll
            for (int q = 0; q < 2; ++q) { const int row = q * 8 + (lane >> 3), ch = lane & 7; const u32x4 v = *(const LAS u32x4*)(stg + row * 64 + ch * 8);
                const size_t t = cur.rowbase + (size_t)(cur.c + ((cur.U0 + 32 * w4 + 16 * ps + row) << cur.sh)); *(u32x4*)(PO + (t * 6 + cur.h) * 64 + ch * 8) = v; }
        }
        if (i + 1 < n) { const bf16* qrow = a.Pb + (size_t)(a.c + ((a.U0 + 32 * w4 + r32) << a.sh)) * NINP + COL_AQ + a.h * 64 + hi * 8;
#pragma unroll
            for (int k = 0; k < 4; ++k) qf[k] = *(const bf16x8*)(qrow + 16 * k); }
    }
    asm volatile("s_waitcnt vmcnt(0) lgkmcnt(0)\n\ts_barrier" ::: "memory");
}
__device__ __forceinline__ void ph_acomb(Frame& F) {
    unsigned char* ws = F.a->ws; const bf16* PO = (const bf16*)(ws + WS_AP); const float* PM = (const float*)(ws + WS_AP + AP_PO_BYTES); const float* PL = (const float*)(ws + WS_AP + AP_PO_BYTES + AP_ML_BYTES); bf16* O = (bf16*)(ws + WS_O);
#pragma unroll 2
    for (int i = blockIdx.x * NTHR + F.tid; i < M * 6 * 8; i += GRID * NTHR) { const int th = i >> 3, ch = i & 7, t = th / 6, h = th % 6;
        float mm[3], ll[3], mx = -1e30f;
#pragma unroll
        for (int p = 0; p < 3; ++p) { mm[p] = PM[((size_t)p * M + t) * 6 + h]; ll[p] = PL[((size_t)p * M + t) * 6 + h]; mx = fmaxf(mx, mm[p]); }
        float den = 0.f, acc[8];
#pragma unroll
        for (int j = 0; j < 8; ++j) acc[j] = 0.f;
#pragma unroll
        for (int p = 0; p < 3; ++p) { const float w = exp2f(mm[p] - mx) * ll[p]; den += w; float v[8]; ld8(PO + (((size_t)p * M + t) * 6 + h) * 64 + ch * 8, v);
#pragma unroll
            for (int j = 0; j < 8; ++j) acc[j] += w * v[j]; }
        const float id = 1.0f / den; float ss = 0.f;
#pragma unroll
        for (int j = 0; j < 8; ++j) { acc[j] *= id; ss += acc[j] * acc[j]; }
        ss += __shfl_xor(ss, 1); ss += __shfl_xor(ss, 2); ss += __shfl_xor(ss, 4);
        const float rstd = 1.0f / sqrtf(ss * (1.0f / 64.0f) + 1e-6f);
#pragma unroll
        for (int j = 0; j < 8; ++j) acc[j] *= rstd;
        store8(O + (size_t)t * D + h * 64 + ch * 8, acc); }
}
#ifndef MK_SPLIT
#define MK_SPLIT 0
#endif
__global__ void __launch_bounds__(NTHR, 2) mk_fwd(Args args) {
    extern __shared__ __attribute__((aligned(16))) unsigned char lds_raw[];
    Frame F; F.lds = (LAS unsigned char*)lds_raw; F.tid = threadIdx.x; F.lane = F.tid & 63; F.wave = __builtin_amdgcn_readfirstlane(F.tid >> 6);
    { const int bx = blockIdx.x; F.vcu = (bx % 8) * (GRID / 8) + bx / 8; } F.gw = F.vcu * NWAVES + F.wave; F.a = (CArgs*)__builtin_amdgcn_kernarg_segment_ptr();
    volatile LAS unsigned* MISC = (volatile LAS unsigned*)(F.lds + LDS_MISC);
    if (F.tid < 32) MISC[F.tid] = 0u;
    __syncthreads();
#if !MK_SPLIT
    XcdBarrier bar = xcd_barrier_post((unsigned*)(args.ws + WS_CTL) + CW_BAR, MISC);
#define GRID_BAR() do { PH_BEGIN(); xcd_barrier(bar, F.tid); } while (0)
#else
#define GRID_BAR() do {} while (0)
#endif
    const int lo = args.ph_lo, hi = args.ph_hi;
#define IN(k) (lo <= (k) && (k) < hi)
#define PH_BEGIN() do { int t_ = (int)__builtin_amdgcn_mbcnt_hi(~0u, __builtin_amdgcn_mbcnt_lo(~0u, 0u)); int w_ = F.wave; CArgs* a_ = (CArgs*)__builtin_amdgcn_kernarg_segment_ptr(); asm volatile("" : "+v"(t_), "+s"(w_), "+s"(a_)); F.wave = w_; F.lane = t_; F.tid = w_ * 64 + t_; F.a = a_; } while (0)
#define SEAM(k) do { if (IN(k) && IN((k) + 1)) GRID_BAR(); } while (0)
    LAS int* rows = (LAS int*)(F.lds + LDS_ROWS); LAS float* rs = (LAS float*)(F.lds + LDS_RS);
#define ws (F.a->ws)
#define XN ((bf16*)(ws + WS_X))
#define P ((bf16*)(ws + WS_R1))
#define ACT ((bf16*)(ws + WS_R1))
#define U ((bf16*)(ws + WS_R2))
#define O ((bf16*)(ws + WS_O))
#define Y ((bf16*)(ws + WS_R2))
#define TAB ((const float*)(ws + WS_TAB))
    for (int l = 0; l < DEPTH; ++l) {
        const int pb = 8 * l;
        if (IN(pb + 0)) { PH_BEGIN(); if (l == 0) ph_tab(F); if (F.a->sub & 1) ph_wconv(F, l); if (F.a->sub & 2) ph_entry(F, l == 0 ? 0 : 1); }
        SEAM(pb + 0);
        if (IN(pb + 1)) { PH_BEGIN(); pg8::Gemm g{XN, (const bf16*)(ws + WS_WIN), D, D, D}; pg8::PanelOrder<false> Sd{F.vcu >> 1, 5 * (F.vcu & 1), 5, (size_t)256 * D * 2, (size_t)256 * D * 2, 0, nullptr};
            pg8::EpiIn E{P, TAB, (const float*)(ws + WS_RSTDA)}; pg8::gemm_phase<pg8::EpiIn, pg8::PanelOrder<false>, false>(F.lds, g, Sd, E, F.tid); }
        SEAM(pb + 1);
        if (IN(pb + 2)) { PH_BEGIN(); const int pm = F.vcu >> 1; if (F.a->sub & 1) {
            { const int r = F.tid >> 1, part = F.tid & 1; const bf16* pr = P + (size_t)(pm * 256 + r) * NINP + (part ? COL_CKV : COL_CQ); const int nch = part ? 16 : 24; float s = 0.f;
#pragma unroll 1
                for (int c0 = 0; c0 < nch; c0 += 8) { u32x4 w[8];
#pragma unroll
                    for (int c = 0; c < 8; ++c) w[c] = *(const u32x4*)(pr + 8 * (c0 + c));
#pragma unroll
                    for (int c = 0; c < 8; ++c) { const float a0 = bf2f(w[c].x & 0xffffu), a1 = bf2f(w[c].x >> 16), a2 = bf2f(w[c].y & 0xffffu), a3 = bf2f(w[c].y >> 16), a4 = bf2f(w[c].z & 0xffffu), a5 = bf2f(w[c].z >> 16), a6 = bf2f(w[c].w & 0xffffu), a7 = bf2f(w[c].w >> 16);
                        s += (a0 * a0 + a1 * a1) + (a2 * a2 + a3 * a3) + (a4 * a4 + a5 * a5) + (a6 * a6 + a7 * a7); } }
                rs[2 * r + part] = part ? 1.0f / sqrtf(s * (1.0f / 128.0f) + 1e-6f) : QS_C / sqrtf(s * (1.0f / 192.0f) + 1e-6f); }
            __syncthreads();
            pg8::Gemm g{P + COL_CQ, (const bf16*)(ws + WS_WUP), NINP, KUP, KUP}; pg8::PanelOrder<false> Sd{pm, (F.vcu & 1) ? 3 : 0, (F.vcu & 1) ? 2 : 3, (size_t)256 * NINP * 2, (size_t)256 * KUP * 2, 0, nullptr};
            pg8::EpiUp E{U, TAB, rs}; pg8::gemm_phase<pg8::EpiUp, pg8::PanelOrder<false>, true>(F.lds, g, Sd, E, F.tid); } if (F.a->sub & 2) { PH_BEGIN(); ph_apat2(F, MISC); } }
        SEAM(pb + 2);
        if (IN(pb + 3)) { if (F.a->sub & 1) { PH_BEGIN(); ph_acomb(F); } PH_BEGIN(); ph_attn_bc(F, l); }
        SEAM(pb + 3);
        if (IN(pb + 4)) { PH_BEGIN(); pg8::Gemm g{O, (const bf16*)(ws + WS_WOUT), D, D, D}; pg8::PanelOrder<false> Sd{F.vcu >> 1, 2 * (F.vcu & 1), 2, (size_t)256 * D * 2, (size_t)256 * D * 2, 0, nullptr};
            pg8::EpiOut E{XN, l == 0 ? F.a->in[0] : (const float*)nullptr}; pg8::gemm_phase<pg8::EpiOut, pg8::PanelOrder<false>, true>(F.lds, g, Sd, E, F.tid); }
        SEAM(pb + 4);
        if (IN(pb + 5)) { PH_BEGIN(); ph_router(F, l); }
        SEAM(pb + 5);
        if (IN(pb + 6)) { PH_BEGIN(); const int e = F.vcu >> 4, b = (F.vcu >> 1) & 7, half = F.vcu & 1;
            topk_select(F, b, e, half, rows);
            pg8::Gemm g{XN, (const bf16*)(ws + WS_WGU), D, D, D}; pg8::PairOrder<true> Sd{F.vcu & ~1, half, 11, 6, 0, (size_t)256 * D * 2, (size_t)e * NGU * D * 2, rows};
            pg8::EpiG1 E{ACT, (const float*)(ws + WS_RSTD), rows}; pg8::gemm_phase<pg8::EpiG1, pg8::PairOrder<true>, false>(F.lds, g, Sd, E, F.tid); }
        if (IN(pb + 6) && IN(pb + 7)) { PH_BEGIN(); asm volatile("s_waitcnt vmcnt(0)" ::: "memory"); __syncthreads();
            if (F.tid == 0) { unsigned* ctr = (unsigned*)(ws + WS_CTL) + CW_PAIR + 64 * (128 * l + (F.vcu >> 1)); unsigned* tmo = (unsigned*)(ws + WS_CTL) + CW_BAR;
                __builtin_amdgcn_fence(__ATOMIC_RELEASE, "agent"); asm volatile("s_waitcnt vmcnt(0)" ::: "memory");
                xb_add(ctr, 1u); XB_SPIN(xb_ld(ctr) < 2u, tmo);
                __builtin_amdgcn_fence(__ATOMIC_ACQUIRE, "agent"); asm volatile("s_waitcnt vmcnt(0)" ::: "memory"); }
            __syncthreads(); }
        if (IN(pb + 7)) { PH_BEGIN(); const int e = F.vcu >> 4;
            pg8::Gemm g{ACT, (const bf16*)(ws + WS_WD), FF, FF, FF}; pg8::PairOrder<false> Sd{F.vcu & ~1, F.vcu & 1, 4, 2, (size_t)256 * FF * 2, (size_t)256 * FF * 2, (size_t)e * D * FF * 2, nullptr};
            pg8::EpiBf16 E{Y, D}; pg8::gemm_phase<pg8::EpiBf16, pg8::PairOrder<false>, false>(F.lds, g, Sd, E, F.tid); }
        SEAM(pb + 7);
    }
    if (IN(8 * DEPTH)) { PH_BEGIN(); ph_entry(F, 2); }
#undef IN
#undef SEAM
#undef ws
#undef XN
#undef P
#undef ACT
#undef U
#undef O
#undef Y
#undef TAB
}

extern "C" void kernel_launch(void* const* d_in, const int* in_sizes, int n_in, void* d_out, int out_size, void* d_ws, size_t ws_size, hipStream_t stream) {
    static int ready = 0;
    if (ready == 0) {
        if (n_in != 22 || out_size != M * D || ws_size < WS_END) { fprintf(stderr, "kernel_launch: unexpected shapes (n_in %d out %d ws %zu)\n", n_in, out_size, ws_size); ready = -1; return; }
        int dev = 0, cus = 0, per_cu = 0; hipGetDevice(&dev); hipDeviceGetAttribute(&cus, hipDeviceAttributeMultiprocessorCount, dev);
        if (hipFuncSetAttribute((const void*)mk_fwd, hipFuncAttributeMaxDynamicSharedMemorySize, LDS_BYTES) != hipSuccess) { fprintf(stderr, "kernel_launch: hipFuncSetAttribute failed\n"); ready = -1; return; }
        hipOccupancyMaxActiveBlocksPerMultiprocessor(&per_cu, (const void*)mk_fwd, NTHR, LDS_BYTES); (void)hipGetLastError();
        if (cus < GRID || per_cu < 1) fprintf(stderr, "kernel_launch: note: %d CUs, occupancy %d; the grid is %d workgroups, one per CU\n", cus, per_cu, GRID);
        ready = 1;
    }
    if (ready < 0) return;
    hipMemsetAsync((char*)d_ws + WS_CTL, 0, CTL_BYTES, stream);
    Args a{}; for (int i = 0; i < 22; ++i) a.in[i] = (const float*)d_in[i];
    a.out = (float*)d_out; a.ws = (unsigned char*)d_ws;
    a.sub = 7;
#if MK_SPLIT
    for (int ph = 0; ph < NPHASE; ++ph) { a.ph_lo = ph; a.ph_hi = ph + 1; a.sub = 7; hipLaunchKernelGGL(mk_fwd, dim3(GRID), dim3(NTHR), LDS_BYTES, stream, a);
        if (PROBE_DUP >= 0 && ((ph < 8 * DEPTH && (ph & 7) == PROBE_DUP) || ph == PROBE_DUP)) { a.sub = PROBE_SUB; for (int r = 0; r < PROBE_REPS; ++r) hipLaunchKernelGGL(mk_fwd, dim3(GRID), dim3(NTHR), LDS_BYTES, stream, a); } }
#else
    a.ph_lo = 0; a.ph_hi = NPHASE; hipLaunchKernelGGL(mk_fwd, dim3(GRID), dim3(NTHR), LDS_BYTES, stream, a);
#endif
}
```

```cpp
#include <hip/hip_runtime.h>
#include <cstdio>
#include <cstdint>

typedef unsigned short bf16;
typedef float f32x4 __attribute__((ext_vector_type(4)));
typedef unsigned u32x4 __attribute__((ext_vector_type(4)));
typedef unsigned u32x2 __attribute__((ext_vector_type(2)));

constexpr int NB = 8, S = 4096, M = NB * S, D = 1024, DEPTH = 2;
constexpr int NIN = 2464, NINP = 2560;
constexpr int COL_AQ = 0, COL_AK = 384, COL_AV = 768, COL_BQ = 1152, COL_BK = 1472, COL_BV = 1792, COL_CQ = 2112, COL_CKV = 2304, COL_CKR = 2432;
constexpr int NUP = 1280, KUP = 384;
constexpr int UCOL_KV = 512;
constexpr int NE = 16, CAP = 512, FF = 1408, NGU = 2 * FF;
constexpr int MR = NE * NB * CAP;
constexpr int TABW = 56;
constexpr float LOG2E = 1.4426950408889634f;
constexpr float QS_A = 0.125f * LOG2E, QS_B = 0.17677669529663687f * LOG2E, QS_C = 0.10206207261596575f * LOG2E;

constexpr size_t MiB = 1u << 20;
constexpr size_t WS_CTL = 0, CTL_BYTES = 1 * MiB;
constexpr size_t WS_TAB = 1 * MiB;
constexpr size_t WS_AFF = 8 * MiB;
constexpr size_t WS_IDX = 10 * MiB;
constexpr size_t WS_GATE = 10 * MiB + 256 * 1024;
constexpr size_t WS_SEL = 10 * MiB + 512 * 1024;
constexpr size_t WS_RSTD = 13 * MiB;
constexpr size_t WS_RSTDA = 13 * MiB + 256 * 1024;
constexpr size_t WS_WIN = 14 * MiB;
constexpr size_t WS_WOUT = 19 * MiB;
constexpr size_t WS_WUP = 21 * MiB;
constexpr size_t WS_WGU = 22 * MiB;
constexpr size_t WS_WD = 110 * MiB;
constexpr size_t WS_X = 154 * MiB;
constexpr size_t WS_R1 = 282 * MiB;
constexpr size_t WS_R2 = 458 * MiB;
constexpr size_t WS_O = WS_R2 + 80 * MiB;
constexpr size_t WS_AP = 602 * MiB;
constexpr size_t AP_PO_BYTES = (size_t)3 * M * 6 * 64 * 2, AP_ML_BYTES = (size_t)3 * M * 6 * 4;
constexpr size_t WS_END = 682 * MiB;
static_assert(WS_AP + AP_PO_BYTES + 2 * AP_ML_BYTES <= WS_END, "ws map");

__device__ __forceinline__ unsigned f2bf(float f) { unsigned u = __builtin_bit_cast(unsigned, f); return (u + 0x7fffu + ((u >> 16) & 1u)) >> 16; }
__device__ __forceinline__ float bf2f(unsigned h) { return __builtin_bit_cast(float, h << 16); }
__device__ __forceinline__ unsigned pk2(float lo, float hi) { return f2bf(lo) | (f2bf(hi) << 16); }
__device__ __forceinline__ float wave_sum(float v) {
#pragma unroll
    for (int o = 1; o < 64; o <<= 1) v += __shfl_xor(v, o);
    return v;
}
__host__ __device__ __forceinline__ int perm16(int p) { return 4 * (p >> 3) + (p & 3) + 8 * ((p >> 2) & 1); }
__host__ __device__ __forceinline__ int perm32c(int p) { return 4 * (p >> 3) + (p & 3) + 16 * ((p >> 2) & 1); }
__host__ __device__ __forceinline__ int inproj_src(int n) {
    if (n >= NIN) return -1;
    if (n < COL_AV) { const int p = n & 63; return p < 16 ? (n - p) + perm16(p) : n; }
    if (n >= COL_CKR) return COL_CKR + perm32c(n - COL_CKR);
    return n;
}

#define GAS __attribute__((address_space(1)))
#define LAS __attribute__((address_space(3)))
enum { WM_IN = 0, WM_OUT = 1, WM_UP = 2, WM_GU = 3, WM_DN = 4 };
__device__ __forceinline__ void store8(bf16* p, const float* v) { u32x4 w; w.x = pk2(v[0], v[1]); w.y = pk2(v[2], v[3]); w.z = pk2(v[4], v[5]); w.w = pk2(v[6], v[7]); *(u32x4*)p = w; }
__device__ __forceinline__ void ld8(const bf16* p, float* v) { const u32x4 w = *(const u32x4*)p; v[0] = bf2f(w.x & 0xffffu); v[1] = bf2f(w.x >> 16); v[2] = bf2f(w.y & 0xffffu); v[3] = bf2f(w.y >> 16);
    v[4] = bf2f(w.z & 0xffffu); v[5] = bf2f(w.z >> 16); v[6] = bf2f(w.w & 0xffffu); v[7] = bf2f(w.w >> 16); }
namespace pg8 {
#define PG8_LAS __attribute__((address_space(3)))
typedef unsigned short bf16_t;
typedef short bf16x8 __attribute__((ext_vector_type(8)));
constexpr int BM = 256, BK = 64, HALF = 128, HTB = HALF * BK * 2  , STAGE_BYTES = 8 * HTB;
__host__ __device__ __forceinline__ int lds_byte(int r, int c) { const int st = (r >> 4) * 2 + (c >> 5), rr = r & 15, cc = c & 31, ob = rr * 64 + cc * 2; return st * 1024 + (ob ^ (((ob >> 9) & 1) << 5)); }
__host__ __device__ __forceinline__ void stage_rc(int b, int& R, int& C) { const int st = b / 1024, sb = b % 1024, swz = sb ^ (((sb >> 9) & 1) << 5); R = (st >> 1) * 16 + swz / 64; C = (st & 1) * 32 + (swz % 64) / 2; }
__host__ __device__ __forceinline__ int perm32(int rho) { const int n = rho >> 4, i = rho & 15; return 8 * (i >> 2) + 4 * n + (i & 3); }
struct Unit { int pm, pn; };
struct Gemm { const bf16_t* A; const bf16_t* Bt; int lda, ldb, K; };
template <bool GATHER_> struct PanelOrder {
    static constexpr bool GATHER = GATHER_;
    int pm, pn0, cnt; size_t a_tile, b_tile, b_base; const PG8_LAS int* rows;
    __device__ __forceinline__ bool next(int i, Unit& u) const { if (i >= cnt) return false; u.pm = pm; u.pn = pn0 + i; return true; }
    __device__ __forceinline__ size_t a_off(const Unit& u) const { return GATHER_ ? (size_t)0 : (size_t)u.pm * a_tile; }
    __device__ __forceinline__ size_t b_off(const Unit& u) const { return b_base + (size_t)u.pn * b_tile; }
    __device__ __forceinline__ const PG8_LAS int* rows_of(const Unit&) const { return rows; }
};
template <bool GATHER_> struct PairOrder {
    static constexpr bool GATHER = GATHER_;
    int pm0, h, nt, c0; size_t a_tile, b_tile, b_base; const PG8_LAS int* rows;
    __device__ __forceinline__ bool next(int i, Unit& u) const { if (i >= nt) return false; const int n0 = h ? nt - c0 : c0;
        if (i < n0) { u.pm = pm0; u.pn = (h ? c0 : 0) + i; } else { u.pm = pm0 + 1; u.pn = (h ? nt - c0 : 0) + (i - n0); } return true; }
    __device__ __forceinline__ size_t a_off(const Unit& u) const { return GATHER_ ? (size_t)0 : (size_t)u.pm * a_tile; }
    __device__ __forceinline__ size_t b_off(const Unit& u) const { return b_base + (size_t)u.pn * b_tile; }
    __device__ __forceinline__ const PG8_LAS int* rows_of(const Unit& u) const { return rows + 256 * (u.pm & 1); }
};
__device__ __forceinline__ unsigned cvt_pk_bf16(float lo, float hi) { unsigned r; asm volatile("v_cvt_pk_bf16_f32 %0, %1, %2" : "=v"(r) : "v"(lo), "v"(hi)); return r; }
__device__ __forceinline__ void rope4(f32x4& v0, f32x4& v1, const float* cs, const float* sn) {
    const f32x4 c = *(const f32x4*)cs, s = *(const f32x4*)sn; const f32x4 a = v0 * c - v1 * s, b = v1 * c + v0 * s; v0 = a; v1 = b; }
struct EpiIn {
    static constexpr bool PERM = true, AFTER_DRAIN = false, INIT_LOAD = false;
    bf16_t* P; const float* tab; const float* RSA;
    __device__ __forceinline__ void operator()(const f32x4 (&acc)[2][2][4][2], const Unit& u, int wr, int wc, int fr_, int fq_) const {
        int fr = fr_, fq = fq_; asm volatile("" : "+v"(fr), "+v"(fq));
        const int row0 = u.pm * BM + wr * 64 + fr;
        float rsa[2][4];
#pragma unroll
        for (int ai = 0; ai < 2; ++ai)
#pragma unroll
            for (int m = 0; m < 4; ++m) rsa[ai][m] = RSA[row0 + ai * HALF + m * 16];
#pragma unroll
        for (int bj = 0; bj < 2; ++bj) {
            const int gcol = u.pn * BM + bj * HALF + wc * 32;
            int cso = -1, sno = 0; float sc = 1.f; bool grope = false;
            if (gcol < COL_AV) { grope = (gcol & 63) == 0; if (grope && fq < 2) { cso = 4 * fq; sno = 8 + 4 * fq; } if (gcol < COL_AK) sc = QS_A; }
            else if (gcol >= COL_BQ && gcol < COL_BV) { grope = true; if (fq == 0) { cso = 16; sno = 20; } if (gcol < COL_BK) sc = QS_B; }
            else if (gcol == COL_CKR) { grope = true; cso = 24 + 4 * fq; sno = 40 + 4 * fq; }
            const int co = cso >= 0 ? cso : 0;
#pragma unroll
            for (int ai = 0; ai < 2; ++ai) {
                f32x4 cs[4], sn[4];
                if (grope) {
#pragma unroll
                    for (int m = 0; m < 4; ++m) { const float* tb = tab + (size_t)(row0 + ai * HALF + m * 16) * TABW; cs[m] = *(const f32x4*)(tb + co); sn[m] = *(const f32x4*)(tb + sno); } }
#pragma unroll
                for (int m = 0; m < 4; ++m) { const int t = row0 + ai * HALF + m * 16; f32x4 v0 = acc[ai][bj][m][0], v1 = acc[ai][bj][m][1];
                    if (grope && cso >= 0) { const f32x4 a = v0 * cs[m] - v1 * sn[m], b = v1 * cs[m] + v0 * sn[m]; v0 = a; v1 = b; }
                    const float scr = sc * rsa[ai][m]; v0 = v0 * scr; v1 = v1 * scr;
                    u32x4 w; w.x = cvt_pk_bf16(v0[0], v0[1]); w.y = cvt_pk_bf16(v0[2], v0[3]); w.z = cvt_pk_bf16(v1[0], v1[1]); w.w = cvt_pk_bf16(v1[2], v1[3]);
                    *(u32x4*)(P + (size_t)t * NINP + gcol + 8 * fq) = w; }
                asm volatile("" ::: "memory"); }
        }
    }
};
struct EpiUp {
    static constexpr bool PERM = true, AFTER_DRAIN = false, INIT_LOAD = false;
    bf16_t* U; const float* tab; const PG8_LAS float* rs;
    __device__ __forceinline__ void operator()(const f32x4 (&acc)[2][2][4][2], const Unit& u, int wr, int wc, int fr_, int fq_) const {
        int fr = fr_, fq = fq_; asm volatile("" : "+v"(fr), "+v"(fq));
        const int lr0 = wr * 64 + fr;
#pragma unroll
        for (int bj = 0; bj < 2; ++bj) {
            const int gcol = u.pn * BM + bj * HALF + wc * 32; const bool isq = gcol < UCOL_KV; const bool rope = gcol < 480 && ((gcol >> 5) % 3) == 2;
#pragma unroll
            for (int ai = 0; ai < 2; ++ai) {
                f32x4 cs[4], sn[4];
                if (rope) {
#pragma unroll
                    for (int m = 0; m < 4; ++m) { const float* tb = tab + (size_t)(u.pm * BM + lr0 + ai * HALF + m * 16) * TABW; cs[m] = *(const f32x4*)(tb + 24 + 4 * fq); sn[m] = *(const f32x4*)(tb + 40 + 4 * fq); } }
#pragma unroll
                for (int m = 0; m < 4; ++m) { const int lr = lr0 + ai * HALF + m * 16, t = u.pm * BM + lr; f32x4 v0 = acc[ai][bj][m][0], v1 = acc[ai][bj][m][1];
                    const float sc = rs[2 * lr + (isq ? 0 : 1)];
                    if (rope) { const f32x4 a = v0 * cs[m] - v1 * sn[m], b = v1 * cs[m] + v0 * sn[m]; v0 = a; v1 = b; }
                    v0 = v0 * sc; v1 = v1 * sc;
                    u32x4 w; w.x = cvt_pk_bf16(v0[0], v0[1]); w.y = cvt_pk_bf16(v0[2], v0[3]); w.z = cvt_pk_bf16(v1[0], v1[1]); w.w = cvt_pk_bf16(v1[2], v1[3]);
                    *(u32x4*)(U + (size_t)t * NUP + gcol + 8 * fq) = w; }
                asm volatile("" ::: "memory"); }
        }
    }
};
struct EpiOut {
    static constexpr bool PERM = true, AFTER_DRAIN = false, INIT_LOAD = true;
    bf16_t* XB; const float* XI;
    __device__ __forceinline__ void load_init(f32x4 (&acc)[2][2][4][2], const Unit& u, int wr, int wc, int fr_, int fq_) const {
        int fr = fr_, fq = fq_; asm volatile("" : "+v"(fr), "+v"(fq));
        const int row0 = u.pm * BM + wr * 64 + fr, col0 = u.pn * BM + wc * 32 + 8 * fq;
#pragma unroll
        for (int ai = 0; ai < 2; ++ai)
#pragma unroll
            for (int m = 0; m < 4; ++m) { const size_t off = (size_t)(row0 + ai * HALF + m * 16) * D + col0;
#pragma unroll
                for (int bj = 0; bj < 2; ++bj) {
                    if (XI) { acc[ai][bj][m][0] = *(const f32x4*)(XI + off + bj * HALF); acc[ai][bj][m][1] = *(const f32x4*)(XI + off + bj * HALF + 4); }
                    else { const u32x4 w = *(const u32x4*)(XB + off + bj * HALF);
                        acc[ai][bj][m][0] = (f32x4){bf2f(w.x & 0xffffu), bf2f(w.x >> 16), bf2f(w.y & 0xffffu), bf2f(w.y >> 16)}; acc[ai][bj][m][1] = (f32x4){bf2f(w.z & 0xffffu), bf2f(w.z >> 16), bf2f(w.w & 0xffffu), bf2f(w.w >> 16)}; } } }
    }
    __device__ __forceinline__ void operator()(const f32x4 (&acc)[2][2][4][2], const Unit& u, int wr, int wc, int fr_, int fq_) const {
        int fr = fr_, fq = fq_; asm volatile("" : "+v"(fr), "+v"(fq));
        const int row0 = u.pm * BM + wr * 64 + fr, col0 = u.pn * BM + wc * 32 + 8 * fq;
#pragma unroll
        for (int ai = 0; ai < 2; ++ai)
#pragma unroll
            for (int m = 0; m < 4; ++m) { bf16_t* rowp = XB + (size_t)(row0 + ai * HALF + m * 16) * D + col0;
#pragma unroll
                for (int bj = 0; bj < 2; ++bj) { const f32x4 v0 = acc[ai][bj][m][0], v1 = acc[ai][bj][m][1];
                    u32x4 w; w.x = cvt_pk_bf16(v0[0], v0[1]); w.y = cvt_pk_bf16(v0[2], v0[3]); w.z = cvt_pk_bf16(v1[0], v1[1]); w.w = cvt_pk_bf16(v1[2], v1[3]);
                    *(u32x4*)(rowp + bj * HALF) = w; } }
    }
};
struct EpiG1 {
    static constexpr bool PERM = true, AFTER_DRAIN = false, INIT_LOAD = false;
    bf16_t* ACT; const float* RSTD; const PG8_LAS int* rows;
    __device__ __forceinline__ void operator()(const f32x4 (&acc)[2][2][4][2], const Unit& u, int wr, int wc, int fr_, int fq_) const {
        int fr = fr_, fq = fq_; asm volatile("" : "+v"(fr), "+v"(fq));
        const int row0 = u.pm * BM + wr * 64 + fr, col0 = u.pn * HALF + wc * 32 + 8 * fq;
        float rsdv[2][4];
#pragma unroll
        for (int ai = 0; ai < 2; ++ai)
#pragma unroll
            for (int m = 0; m < 4; ++m) rsdv[ai][m] = RSTD[rows[(u.pm & 1) * BM + ai * HALF + wr * 64 + m * 16 + fr]];
#pragma unroll
        for (int ai = 0; ai < 2; ++ai)
#pragma unroll
            for (int m = 0; m < 4; ++m) { float a[8]; const float rsd = rsdv[ai][m];
#pragma unroll
                for (int n = 0; n < 2; ++n)
#pragma unroll
                    for (int j = 0; j < 4; ++j) { const float g = acc[ai][0][m][n][j] * rsd, up = acc[ai][1][m][n][j] * rsd;
                        a[4 * n + j] = g * __builtin_amdgcn_rcpf(1.0f + __builtin_amdgcn_exp2f(-g * LOG2E)) * up; }
                u32x4 w; w.x = cvt_pk_bf16(a[0], a[1]); w.y = cvt_pk_bf16(a[2], a[3]); w.z = cvt_pk_bf16(a[4], a[5]); w.w = cvt_pk_bf16(a[6], a[7]);
                *(u32x4*)(ACT + (size_t)(row0 + ai * HALF + m * 16) * FF + col0) = w; }
    }
};
struct EpiBf16 {
    static constexpr bool PERM = true, AFTER_DRAIN = false, INIT_LOAD = false;
    bf16_t* O; int ldc;
    __device__ __forceinline__ void operator()(const f32x4 (&acc)[2][2][4][2], const Unit& u, int wr, int wc, int fr_, int fq_) const {
        int fr = fr_, fq = fq_; asm volatile("" : "+v"(fr), "+v"(fq));
        const int row0 = u.pm * BM + wr * 64 + fr, col0 = u.pn * BM + wc * 32 + 8 * fq;
#pragma unroll
        for (int ai = 0; ai < 2; ++ai)
#pragma unroll
            for (int m = 0; m < 4; ++m) { bf16_t* rowp = O + (size_t)(row0 + ai * HALF + m * 16) * ldc + col0;
#pragma unroll
                for (int bj = 0; bj < 2; ++bj) { const f32x4 v0 = acc[ai][bj][m][0], v1 = acc[ai][bj][m][1];
                    u32x4 w; w.x = cvt_pk_bf16(v0[0], v0[1]); w.y = cvt_pk_bf16(v0[2], v0[3]); w.z = cvt_pk_bf16(v1[0], v1[1]); w.w = cvt_pk_bf16(v1[2], v1[3]);
                    *(u32x4*)(rowp + bj * HALF) = w; } }
    }
};

template <class Epi, class Sched, bool ALIGN_EPI>
__device__ __forceinline__ void gemm_phase(PG8_LAS unsigned char* lds, const Gemm g, const Sched& S, const Epi& E, int tid_in) {
    int tid_ = tid_in; asm volatile("" : "+v"(tid_));
    const int tid = tid_, wid = __builtin_amdgcn_readfirstlane(tid >> 6), lane = tid & 63, wr = wid >> 2, wc = wid & 3, fr = lane & 15, fq = lane >> 4;
    const int K = g.K, nt = K / BK;
    unsigned voffA0[2], voffA1[2], voffB[2];
    Unit cur, nxt; int ui = 0;
    if (!S.next(0, cur)) return;
#pragma unroll
    for (int i = 0; i < 2; ++i) { int R, C; stage_rc(tid * 16 + i * 8192, R, C); const int Rb = Epi::PERM ? ((R & ~31) + perm32(R & 31)) : R;
        if constexpr (Sched::GATHER) { const PG8_LAS int* rw = S.rows_of(cur); voffA0[i] = (unsigned)rw[R] * (unsigned)(g.lda * 2) + (unsigned)C * 2u; voffA1[i] = (unsigned)rw[R + HALF] * (unsigned)(g.lda * 2) + (unsigned)C * 2u; }
        else { voffA0[i] = (unsigned)(R * g.lda + C) * 2u; voffA1[i] = 0u; }
        voffB[i] = (unsigned)(Rb * g.ldb + C) * 2u; }
    const size_t kstep = (size_t)(BK * 2);
    const size_t hstepB = (size_t)HALF * g.ldb * 2;
    const size_t hstepA = Sched::GATHER ? (size_t)0 : (size_t)HALF * g.lda * 2;
#define PG8_STAGE_A1(bufoff, gbase) do { if constexpr (Sched::GATHER) PG8_STAGE(bufoff, gbase, voffA1); else PG8_STAGE(bufoff, (gbase) + hstepA, voffA0); } while (0)
    const unsigned ldsw = (unsigned)wid * 1024u;
    const int aoff = lds_byte(wr * 64 + fr, fq * 8), boff = lds_byte(wc * 32 + fr, fq * 8);
#define PG8_SA(b, h) (((b) * 2 + (h)) * HTB)
#define PG8_SB(b, h) ((4 + (b) * 2 + (h)) * HTB)
#define PG8_STAGE(bufoff, gbase, voff) do { _Pragma("unroll") for (int _i = 0; _i < 2; ++_i) \
        __builtin_amdgcn_global_load_lds((const unsigned*)((const char*)(gbase) + (voff)[_i]), (PG8_LAS unsigned*)(lds + (bufoff) + ldsw + _i * 8192), 16, 0, 0); } while (0)
#define PG8_LDA(dst, b, h) do { _Pragma("unroll") for (int m = 0; m < 4; ++m) _Pragma("unroll") for (int k = 0; k < 2; ++k) dst[m][k] = *(const PG8_LAS bf16x8*)(lds + PG8_SA(b, h) + aoff + m * 2048 + k * 1024); } while (0)
#define PG8_LDB(dst, b, h) do { _Pragma("unroll") for (int n = 0; n < 2; ++n) _Pragma("unroll") for (int k = 0; k < 2; ++k) dst[n][k] = *(const PG8_LAS bf16x8*)(lds + PG8_SB(b, h) + boff + n * 2048 + k * 1024); } while (0)
#define PG8_MMA(ai, bj, At, Bt) do { __builtin_amdgcn_s_setprio(1); _Pragma("unroll") for (int m = 0; m < 4; ++m) _Pragma("unroll") for (int n = 0; n < 2; ++n) _Pragma("unroll") for (int k = 0; k < 2; ++k) \
        acc[ai][bj][m][n] = __builtin_amdgcn_mfma_f32_16x16x32_bf16(Bt[n][k], At[m][k], acc[ai][bj][m][n], 0, 0, 0); __builtin_amdgcn_s_setprio(0); } while (0)
#define PG8_WAIT_V(n) asm volatile("s_waitcnt vmcnt(" #n ")" ::: "memory")
#define PG8_WAIT_L(n) asm volatile("s_waitcnt lgkmcnt(" #n ")" ::: "memory")
#define PG8_BAR __builtin_amdgcn_s_barrier()
#define PG8_SCHED __builtin_amdgcn_sched_barrier(0)
    f32x4 acc[2][2][4][2];
    if constexpr (Epi::INIT_LOAD) E.load_init(acc, cur, wr, wc, fr, fq);
    else {
#pragma unroll
    for (int a = 0; a < 2; ++a)
#pragma unroll
        for (int b = 0; b < 2; ++b)
#pragma unroll
            for (int m = 0; m < 4; ++m)
#pragma unroll
                for (int n = 0; n < 2; ++n) acc[a][b][m][n] = (f32x4){0.f, 0.f, 0.f, 0.f};
    }
    bf16x8 At[4][2], B0[2][2], B1[2][2];
    const char* cA = (const char*)g.A + S.a_off(cur); const char* cB = (const char*)g.Bt + S.b_off(cur);
    PG8_STAGE(PG8_SB(0, 0), cB, voffB); PG8_STAGE(PG8_SB(0, 1), cB + hstepB, voffB); PG8_STAGE(PG8_SA(0, 0), cA, voffA0); PG8_STAGE_A1(PG8_SA(0, 1), cA);
    if (wr == 1) PG8_BAR;
    PG8_WAIT_V(2); PG8_BAR;
    PG8_STAGE(PG8_SB(1, 0), cB + kstep, voffB); PG8_STAGE(PG8_SA(1, 0), cA + kstep, voffA0); PG8_STAGE(PG8_SB(1, 1), cB + hstepB + kstep, voffB);
    PG8_WAIT_V(6); PG8_BAR;
    for (;;) {
        const bool has_next = S.next(ui + 1, nxt);
        const char* nA = has_next ? (const char*)g.A + S.a_off(nxt) : cA; const char* nB = has_next ? (const char*)g.Bt + S.b_off(nxt) : cB;
#pragma unroll 1
        for (int t = 0; t < nt; t += 2) {
            const bool last = (t == nt - 2);
            const char* a1 = cA + (size_t)(t + 1) * kstep;
            const char* a2 = last ? nA : cA + (size_t)(t + 2) * kstep; const char* b2 = last ? nB : cB + (size_t)(t + 2) * kstep;
            const char* a3 = a2 + kstep; const char* b3 = b2 + kstep;
            PG8_LDB(B0, 0, 0); PG8_LDB(B1, 0, 1); PG8_SCHED; PG8_LDA(At, 0, 0); PG8_STAGE_A1(PG8_SA(1, 1), a1);
            if constexpr (Sched::GATHER) { if (last && has_next && nxt.pm != cur.pm) {
                const PG8_LAS int* rw = S.rows_of(nxt); const int tid2 = wid * 64 + (int)__builtin_amdgcn_mbcnt_hi(~0u, __builtin_amdgcn_mbcnt_lo(~0u, 0u));
#pragma unroll
                for (int i = 0; i < 2; ++i) { int R, C; stage_rc(tid2 * 16 + i * 8192, R, C); voffA0[i] = (unsigned)rw[R] * (unsigned)(g.lda * 2) + (unsigned)C * 2u; voffA1[i] = (unsigned)rw[R + HALF] * (unsigned)(g.lda * 2) + (unsigned)C * 2u; } } }
            PG8_WAIT_V(8); PG8_WAIT_L(0); PG8_BAR; PG8_MMA(0, 0, At, B0); PG8_MMA(0, 1, At, B1); PG8_BAR; PG8_SCHED;
            PG8_LDA(At, 0, 1); PG8_STAGE(PG8_SB(0, 0), b2, voffB); PG8_STAGE(PG8_SB(0, 1), b2 + hstepB, voffB); PG8_STAGE(PG8_SA(0, 0), a2, voffA0);
            PG8_WAIT_V(8); PG8_WAIT_L(0); PG8_BAR; PG8_MMA(1, 0, At, B0); PG8_MMA(1, 1, At, B1); PG8_BAR; PG8_SCHED;
            PG8_LDB(B0, 1, 0); PG8_LDB(B1, 1, 1); PG8_SCHED; PG8_LDA(At, 1, 0); PG8_STAGE_A1(PG8_SA(0, 1), a2);
            PG8_WAIT_V(8); PG8_WAIT_L(0); PG8_BAR; PG8_MMA(0, 0, At, B0); PG8_MMA(0, 1, At, B1); PG8_BAR; PG8_SCHED;
            PG8_LDA(At, 1, 1); PG8_STAGE(PG8_SB(1, 0), b3, voffB); PG8_STAGE(PG8_SB(1, 1), b3 + hstepB, voffB); PG8_STAGE(PG8_SA(1, 0), a3, voffA0);
            PG8_WAIT_V(8); PG8_WAIT_L(0); PG8_BAR; PG8_MMA(1, 0, At, B0); PG8_MMA(1, 1, At, B1); PG8_BAR; PG8_SCHED;
        }
        if constexpr (ALIGN_EPI) { if (wr == 0) PG8_BAR; }
        E(acc, cur, wr, wc, fr, fq);
        if (!has_next) break;
        if constexpr (Epi::INIT_LOAD) E.load_init(acc, nxt, wr, wc, fr, fq);
        else {
#pragma unroll
        for (int a = 0; a < 2; ++a)
#pragma unroll
            for (int b = 0; b < 2; ++b)
#pragma unroll
                for (int m = 0; m < 4; ++m)
#pragma unroll
                    for (int n = 0; n < 2; ++n) acc[a][b][m][n] = (f32x4){0.f, 0.f, 0.f, 0.f};
        }
        cur = nxt; cA = nA; cB = nB; ++ui;
        if constexpr (ALIGN_EPI) { if (wr == 1) PG8_BAR; }
    }
    PG8_WAIT_V(0);
    if constexpr (!ALIGN_EPI) { if (wr == 0) PG8_BAR; }
    PG8_BAR;
#undef PG8_SA
#undef PG8_SB
#undef PG8_STAGE
#undef PG8_STAGE_A1
#undef PG8_LDA
#undef PG8_LDB
#undef PG8_MMA
#undef PG8_WAIT_V
#undef PG8_WAIT_L
#undef PG8_BAR
#undef PG8_SCHED
}
}

#define XB_TMO      128
#define XB_XCNT(j)  (256  + 64 * (j))
#define XB_XSUB(j)  (1280 + 64 * (j))
#define XB_XGEN(j)  (2304 + 64 * (j))
#define XB_TOP      3328
#define XB_TOPGEN   3392
#define XCD_BAR_WORDS 3456
#define XB_SPIN_CAP (1u << 24)

__device__ __forceinline__ unsigned xb_ld(unsigned* p)              { return __hip_atomic_load(p, __ATOMIC_RELAXED, __HIP_MEMORY_SCOPE_AGENT); }
__device__ __forceinline__ unsigned xb_add(unsigned* p, unsigned v) { return __hip_atomic_fetch_add(p, v, __ATOMIC_RELAXED, __HIP_MEMORY_SCOPE_AGENT); }
__device__ __forceinline__ unsigned xb_xcc_id() { return (unsigned)__builtin_amdgcn_s_getreg((3 << 11) | 20) & 0xFu; }
#define XB_SPIN(cond, bar) do { unsigned _sp = 0; while (cond) { __builtin_amdgcn_s_sleep(1); \
    if ((++_sp & 255u) == 0u) { if (xb_ld(&(bar)[XB_TMO])) break; if (_sp > XB_SPIN_CAP) { atomicAdd(&(bar)[XB_TMO], 1u); break; } } } } while (0)

struct XcdBarrier {
    unsigned* bar; unsigned x;
    volatile LAS unsigned* st;
};

__device__ __forceinline__ XcdBarrier xcd_barrier_post(unsigned* bar, volatile LAS unsigned* st) {
    XcdBarrier b; b.bar = bar; b.x = xb_xcc_id(); b.st = st;
    if (threadIdx.x == 0) (void)xb_add(&bar[XB_XCNT(b.x)], 1u);
    return b;
}
__device__ __forceinline__ void xcd_barrier_complete(unsigned* bar, unsigned x, unsigned& nloc, unsigned& nx) {
    const unsigned G = gridDim.x * gridDim.y * gridDim.z;
    unsigned sum, cnt, mine, sp = 0u;
    for (;;) {
        sum = 0u; cnt = 0u; mine = 0u;
#pragma unroll
        for (unsigned j = 0; j < 16; ++j) { const unsigned c = xb_ld(&bar[XB_XCNT(j)]); sum += c; cnt += (c > 0u) ? 1u : 0u; mine = (j == x) ? c : mine; }
        if (sum == G) break;
        __builtin_amdgcn_s_sleep(1);
        if ((++sp & 255u) == 0u) { if (xb_ld(&bar[XB_TMO])) break; if (sp > XB_SPIN_CAP) { atomicAdd(&bar[XB_TMO], 1u); break; } }
    }
    nloc = mine > 0u ? mine : 1u; nx = cnt > 0u ? cnt : 1u;
}

__device__ __forceinline__ void xcd_barrier(const XcdBarrier& b, int tid) {
    asm volatile("s_waitcnt vmcnt(0)" ::: "memory");
    __syncthreads();
    if (tid == 0) {
        unsigned* bar = b.bar;
        __builtin_amdgcn_s_waitcnt(0);
        unsigned nloc = b.st[0], nx = b.st[1];
        if (nloc == 0u) { xcd_barrier_complete(bar, b.x, nloc, nx); b.st[0] = nloc; b.st[1] = nx; }
        const unsigned old = xb_add(&bar[XB_XSUB(b.x)], 1u);
        const unsigned gen = old / nloc;
        if (old + 1u == (gen + 1u) * nloc) {
            __builtin_amdgcn_fence(__ATOMIC_RELEASE, "agent");
            asm volatile("s_waitcnt vmcnt(0)" ::: "memory");
            const unsigned og = xb_add(&bar[XB_TOP], 1u);
            const unsigned tg = og / nx;
            if (og + 1u == (tg + 1u) * nx) xb_add(&bar[XB_TOPGEN], 1u);
            else XB_SPIN(xb_ld(&bar[XB_TOPGEN]) == tg, bar);
            __builtin_amdgcn_fence(__ATOMIC_ACQUIRE, "agent");
            xb_add(&bar[XB_XGEN(b.x)], 1u);
            asm volatile("s_waitcnt vmcnt(0)" ::: "memory");
        } else {
            XB_SPIN(xb_ld(&bar[XB_XGEN(b.x)]) == gen, bar);
            __builtin_amdgcn_fence(__ATOMIC_ACQUIRE, "agent");
            asm volatile("s_waitcnt vmcnt(0)" ::: "memory");
        }
    }
    __syncthreads();
}

constexpr int NWAVES = 8, NTHR = NWAVES * 64, GRID = 256;
constexpr int RING_BYTES = 131072;
constexpr int LDS_ROWS = RING_BYTES;
constexpr int LDS_RS = LDS_ROWS + 2048;
constexpr int LDS_MISC = LDS_RS + 2048;
constexpr int LDS_AP2 = LDS_MISC + 512;
constexpr int LDS_BYTES = 155648;
static_assert(LDS_AP2 + 8 * 2048 + 8 * 256 <= LDS_BYTES, "LDS map");
constexpr int CW_BAR = 4096;
constexpr int CW_PAIR = 16384;
constexpr int NPHASE = 8 * DEPTH + 1;
constexpr int NWC = 2;

struct Args { const float* in[22]; float* out; unsigned char* ws; int ph_lo, ph_hi, sub, pad; };
typedef const __attribute__((address_space(4))) Args CArgs;
struct Frame {
    LAS unsigned char* lds; int tid, lane, wave, vcu, gw;
    CArgs* a;
};
#define LDS_WAIT() asm volatile("s_waitcnt lgkmcnt(0)" ::: "memory")

struct WDesc { int mode; const float* src; const float* src2; const float* g; const float* g2; const float* g3; float gscale; bf16* dst; int K; };
__device__ __forceinline__ float wgain(const WDesc& w, int k) {
    switch (w.mode) {
    case WM_IN: case WM_GU: return w.g[k];
    case WM_OUT: return k < 384 ? w.g[k] : (k < 704 ? w.g2[(k - 384) & 63] * w.gscale : w.g3[k - 704]);
    case WM_UP: return k < 192 ? w.g[k] : (k < 320 ? w.g2[k - 192] : 0.f);
    default: return 1.f; }
}
__device__ __forceinline__ void wconv_tile(const WDesc& w, int n0, int k0, LAS unsigned* scr, int lane) {
    LAS float* gs = (LAS float*)(scr + 32 * 65);
    const int n = n0 + lane; const float* colp = nullptr; int ld = 1, klo = 0, khi = 0;
    switch (w.mode) {
    case WM_IN: { const int c = inproj_src(n); if (c >= 0) { colp = w.src + c; } ld = NIN; khi = D; } break;
    case WM_OUT: colp = w.src + n; ld = D; khi = D; break;
    case WM_UP: if (n < 480) { const int h = n / 96, p = n % 96; colp = w.src + h * 96 + (p < 64 ? p : 64 + perm32c(p - 64)); ld = 480; khi = 192; }
                else if (n >= UCOL_KV && n < UCOL_KV + 640) { colp = w.src2 + (n - UCOL_KV); ld = 640; klo = 192; khi = 320; } break;
    case WM_GU: { const int t = n >> 8, r = n & 255; colp = (r < 128 ? w.src : w.src2) + 128 * t + (r & 127); ld = FF; khi = D; } break;
    default: colp = w.src + n; ld = D; khi = FF; break; }
    const bool ok = colp != nullptr && k0 >= klo && k0 < khi;
    const float* p = ok ? colp + (size_t)(k0 - klo) * ld : w.src; if (!ok) ld = 1;
    gs[lane] = wgain(w, k0 + lane);
    LDS_WAIT(); asm volatile("" ::: "memory");
    const float msk = ok ? 1.f : 0.f;
    { float v[64];
#pragma unroll
      for (int i = 0; i < 64; ++i) v[i] = __builtin_nontemporal_load(p + (size_t)i * ld);
#pragma unroll
      for (int i = 0; i < 64; i += 2) scr[(i >> 1) * 65 + lane] = pk2(v[i] * gs[i] * msk, v[i + 1] * gs[i + 1] * msk); }
    LDS_WAIT(); asm volatile("" ::: "memory");
    const int c = lane & 7;
#pragma unroll
    for (int j = 0; j < 8; ++j) { const int nn = (lane >> 3) + 8 * j; u32x4 o; o.x = scr[(4 * c + 0) * 65 + nn]; o.y = scr[(4 * c + 1) * 65 + nn]; o.z = scr[(4 * c + 2) * 65 + nn]; o.w = scr[(4 * c + 3) * 65 + nn];
        __builtin_nontemporal_store(o, (u32x4*)(w.dst + (size_t)(n0 + nn) * w.K + k0 + 8 * c)); }
    LDS_WAIT(); asm volatile("" ::: "memory");
}
__device__ __forceinline__ void ph_wconv(Frame& F, int l, int part, int wi, int nw) {
    CArgs& A = *F.a; unsigned char* ws = A.ws;
    LAS unsigned* scr = (LAS unsigned*)(F.lds + F.wave * 16384);
    const float lam_init = 0.8f - 0.6f * expf(-0.3f * (float)l);
    constexpr int I_IN = 40 * 16, I_OUT = 16 * 16, I_UP = 20 * 6, I_GU1 = 44 * 16, I_DN1 = 16 * 22, NIT = I_IN + I_OUT + I_UP + NE * (I_GU1 + I_DN1);
    const int it_end = part == 0 ? I_IN + I_OUT + I_UP : NIT;
#pragma unroll 1
    for (int it = (part == 0 ? 0 : I_IN + I_OUT + I_UP) + wi; it < it_end; it += nw) {
        int r = it; WDesc w; w.src2 = nullptr; w.g = nullptr; w.g2 = nullptr; w.g3 = nullptr; w.gscale = 1.f; int nt;
        if (r < I_IN) { w.mode = WM_IN; w.src = A.in[3] + (size_t)l * D * NIN; w.g = A.in[2] + l * D; w.dst = (bf16*)(ws + WS_WIN); w.K = D; nt = 40; }
        else if ((r -= I_IN) < I_OUT) { w.mode = WM_OUT; w.src = A.in[15] + (size_t)l * D * D; w.g = A.in[13] + l * 384; w.g2 = A.in[8] + l * 64; w.g3 = A.in[14] + l * 320; w.gscale = 1.0f - lam_init; w.dst = (bf16*)(ws + WS_WOUT); w.K = D; nt = 16; }
        else if ((r -= I_OUT) < I_UP) { w.mode = WM_UP; w.src = A.in[10] + (size_t)l * 192 * 480; w.src2 = A.in[12] + (size_t)l * 128 * 640; w.g = A.in[9] + l * 192; w.g2 = A.in[11] + l * 128; w.dst = (bf16*)(ws + WS_WUP); w.K = KUP; nt = 20; }
        else { r -= I_UP; const int e = r / (I_GU1 + I_DN1); r -= e * (I_GU1 + I_DN1);
            if (r < I_GU1) { w.mode = WM_GU; w.src = A.in[18] + ((size_t)l * NE + e) * D * FF; w.src2 = A.in[19] + ((size_t)l * NE + e) * D * FF; w.g = A.in[16] + l * D; w.dst = (bf16*)(ws + WS_WGU) + (size_t)e * NGU * D; w.K = D; nt = 44; }
            else { r -= I_GU1; w.mode = WM_DN; w.src = A.in[20] + ((size_t)l * NE + e) * FF * D; w.dst = (bf16*)(ws + WS_WD) + (size_t)e * D * FF; w.K = FF; nt = 16; } }
        wconv_tile(w, (r % nt) * 64, (r / nt) * 64, scr, F.lane);
    }
}
__device__ __forceinline__ void ph_tab(Frame& F) {
    const int* pos = (const int*)F.a->in[1]; float* tab = (float*)(F.a->ws + WS_TAB);
    for (int i = blockIdx.x * NTHR + F.tid; i < M * 28; i += GRID * NTHR) {
        const int t = i / 28, f = i % 28; const float p = (float)pos[t]; float inv; int co, so;
        if (f < 8) { inv = 1.0f / powf(500000.0f, (float)(2 * f) / 16.0f); co = f; so = 8 + f; }
        else if (f < 12) { const int j = f - 8; inv = 1.0f / powf(500000.0f, (float)(2 * j) / 8.0f); co = 16 + j; so = 20 + j; }
        else { const int j = f - 12; inv = 1.0f / powf(10000.0f, (float)(2 * j) / 32.0f); co = 24 + j; so = 40 + j; }
        float s, c; sincosf(p * inv, &s, &c); tab[(size_t)t * TABW + co] = c; tab[(size_t)t * TABW + so] = s; }
}
struct RowGather { u32x4 y[4][2]; float g[4]; int n; };
__device__ __forceinline__ void rg_issue(RowGather& R, unsigned& mask, int selv, int b, const bf16* Y, const float* GATE, int lane) {
    R.n = 0;
#pragma unroll
    for (int k = 0; k < 4; ++k) {
        if (mask != 0u) { const int e = __builtin_ctz(mask); mask &= mask - 1u; const int j = __builtin_amdgcn_readlane(selv, e); const int r = (e * NB + b) * CAP + j;
            R.g[k] = GATE[r]; const u32x4* y = (const u32x4*)(Y + (size_t)r * D) + lane;
#pragma unroll
            for (int q = 0; q < 2; ++q) R.y[k][q] = y[64 * q];
            R.n = k + 1; }
        else { R.g[k] = 0.f;
#pragma unroll
            for (int q = 0; q < 2; ++q) R.y[k][q] = (u32x4){0u, 0u, 0u, 0u}; } }
}
__device__ __forceinline__ void bf8_to_f32(const u32x4 w, f32x4& a, f32x4& b) { a = (f32x4){bf2f(w.x & 0xffffu), bf2f(w.x >> 16), bf2f(w.y & 0xffffu), bf2f(w.y >> 16)}; b = (f32x4){bf2f(w.z & 0xffffu), bf2f(w.z >> 16), bf2f(w.w & 0xffffu), bf2f(w.w >> 16)}; }
__device__ __forceinline__ void rg_add(const RowGather& R, f32x4 (&v)[4]) {
#pragma unroll
    for (int k = 0; k < 4; ++k) { const float g = R.g[k];
#pragma unroll
        for (int q = 0; q < 2; ++q) { f32x4 a, b; bf8_to_f32(R.y[k][q], a, b); v[2 * q] += a * g; v[2 * q + 1] += b * g; } }
}
__device__ __forceinline__ void ph_entry(Frame& F, int mode) {
    CArgs& A = *F.a; unsigned char* ws = A.ws; const float* xin = A.in[0]; bf16* XB = (bf16*)(A.ws + WS_X); float* RSTDA = (float*)(ws + WS_RSTDA);
    const bf16* Y = (const bf16*)(ws + WS_R2); const int* SEL = (const int*)(ws + WS_SEL); const float* GATE = (const float*)(ws + WS_GATE);
    constexpr int STR = GRID * NWAVES;
#pragma unroll 1
    for (int t0 = F.gw; t0 < M; t0 += 2 * STR) {
        const int tt[2] = {t0, t0 + STR};
        f32x4 v[2][4]; int selv[2]; unsigned mask[2] = {0u, 0u}; RowGather R[2];
#pragma unroll
        for (int h = 0; h < 2; ++h) {
            if (mode == 0) { const f32x4* src = (const f32x4*)(xin + (size_t)tt[h] * D) + 2 * F.lane;
#pragma unroll
                for (int j = 0; j < 2; ++j) { v[h][2 * j] = src[128 * j]; v[h][2 * j + 1] = src[128 * j + 1]; } }
            else { selv[h] = SEL[(size_t)tt[h] * NE + (F.lane & 15)]; const u32x4* src = (const u32x4*)(XB + (size_t)tt[h] * D) + F.lane;
#pragma unroll
                for (int j = 0; j < 2; ++j) bf8_to_f32(src[64 * j], v[h][2 * j], v[h][2 * j + 1]); } }
        if (mode != 0) {
#pragma unroll
            for (int h = 0; h < 2; ++h) mask[h] = (unsigned)(__ballot(selv[h] >= 0) & 0xffffull);
#pragma unroll
            for (int h = 0; h < 2; ++h) rg_issue(R[h], mask[h], selv[h], tt[h] / S, Y, GATE, F.lane);
#pragma unroll
            for (int h = 0; h < 2; ++h) rg_add(R[h], v[h]);
            while ((mask[0] | mask[1]) != 0u) {
#pragma unroll
                for (int h = 0; h < 2; ++h) rg_issue(R[h], mask[h], selv[h], tt[h] / S, Y, GATE, F.lane);
#pragma unroll
                for (int h = 0; h < 2; ++h) rg_add(R[h], v[h]); }
        }
#pragma unroll
        for (int h = 0; h < 2; ++h) { const int t = tt[h]; float s = 0.f;
#pragma unroll
            for (int j = 0; j < 4; ++j) s += (v[h][j].x * v[h][j].x + v[h][j].y * v[h][j].y) + (v[h][j].z * v[h][j].z + v[h][j].w * v[h][j].w);
            const float rstd = 1.0f / sqrtf(wave_sum(s) * (1.0f / D) + 1e-6f);
            if (mode == 2) { f32x4* o = (f32x4*)(A.out + (size_t)t * D) + 2 * F.lane; const f32x4* g = (const f32x4*)A.in[21] + 2 * F.lane;
#pragma unroll
                for (int j = 0; j < 2; ++j) { o[128 * j] = v[h][2 * j] * rstd * g[128 * j]; o[128 * j + 1] = v[h][2 * j + 1] * rstd * g[128 * j + 1]; } }
            else { u32x4* o16 = (u32x4*)(XB + (size_t)t * D) + F.lane; if (F.lane == 0) RSTDA[t] = rstd;
#pragma unroll
                for (int j = 0; j < 2; ++j) { u32x4 w; w.x = pk2(v[h][2 * j].x, v[h][2 * j].y); w.y = pk2(v[h][2 * j].z, v[h][2 * j].w); w.z = pk2(v[h][2 * j + 1].x, v[h][2 * j + 1].y); w.w = pk2(v[h][2 * j + 1].z, v[h][2 * j + 1].w); o16[64 * j] = w; } } }
    }
}
__device__ __forceinline__ void ph_router(Frame& F, int l) {
    CArgs& A = *F.a; unsigned char* wsb = A.ws; const bf16* Xp = (const bf16*)(A.ws + WS_X); float* AFF = (float*)(wsb + WS_AFF); float* RSTD = (float*)(wsb + WS_RSTD);
    const float* g = A.in[16] + l * D; const float* wr = A.in[17] + (size_t)l * D * NE;
    LAS float* GW = (LAS float*)F.lds;
    LAS float* XT = (LAS float*)(F.lds + 65536) + F.wave * (16 * 132);
    for (int i = F.tid; i < D * NE / 4; i += NTHR) { const f32x4 w4 = ((const f32x4*)wr)[i]; const float gg = g[i >> 2]; *(LAS f32x4*)(GW + 4 * i) = w4 * gg; }
    __syncthreads();
    const int t0 = F.gw * 16, r = F.lane & 15, q = F.lane >> 4;
    const u32x2* src = (const u32x2*)(Xp + (size_t)(t0 + (F.lane >> 5)) * D) + (F.lane & 31);
    f32x4 acc = (f32x4){0.f, 0.f, 0.f, 0.f}; float ssq = 0.f;
    u32x2 v[8];
#pragma unroll
    for (int i = 0; i < 8; ++i) v[i] = src[(size_t)i * 2 * (D / 4)];
#pragma unroll 1
    for (int c = 0; c < 8; ++c) {
#pragma unroll
        for (int i = 0; i < 8; ++i) *(LAS f32x4*)(XT + (2 * i + (F.lane >> 5)) * 132 + 4 * (F.lane & 31)) = (f32x4){bf2f(v[i].x & 0xffffu), bf2f(v[i].x >> 16), bf2f(v[i].y & 0xffffu), bf2f(v[i].y >> 16)};
        if (c < 7) {
#pragma unroll
            for (int i = 0; i < 8; ++i) v[i] = src[(size_t)i * 2 * (D / 4) + (c + 1) * 32]; }
        LDS_WAIT(); asm volatile("" ::: "memory");
        const LAS float* ap = XT + r * 132 + q; const LAS float* bp = GW + (size_t)(c * 128 + q) * 16 + r;
#pragma unroll
        for (int jj = 0; jj < 32; ++jj) { const float a = ap[4 * jj], b = bp[64 * jj]; ssq += a * a; acc = __builtin_amdgcn_mfma_f32_16x16x4f32(a, b, acc, 0, 0, 0); }
        LDS_WAIT(); asm volatile("" ::: "memory");
    }
    ssq += __shfl_xor(ssq, 16); ssq += __shfl_xor(ssq, 32);
    const float rstd = 1.0f / sqrtf(ssq * (1.0f / D) + 1e-6f);
    if (q == 0) RSTD[t0 + r] = rstd;
    f32x4 aff;
#pragma unroll
    for (int k = 0; k < 4; ++k) { const float rs = __shfl(rstd, 4 * q + k); float lg = acc[k] * rs; float mx = lg;
        mx = fmaxf(mx, __shfl_xor(mx, 1)); mx = fmaxf(mx, __shfl_xor(mx, 2)); mx = fmaxf(mx, __shfl_xor(mx, 4)); mx = fmaxf(mx, __shfl_xor(mx, 8));
        const float ex = expf(lg - mx); float den = ex; den += __shfl_xor(den, 1); den += __shfl_xor(den, 2); den += __shfl_xor(den, 4); den += __shfl_xor(den, 8);
        aff[k] = ex / den; }
    const int b = t0 / S, s0 = t0 % S;
    *(f32x4*)(AFF + ((size_t)b * NE + r) * S + s0 + 4 * q) = aff;
}
__device__ __forceinline__ void topk_select(Frame& F, int b, int e, int half, LAS int* rows) {
    unsigned char* ws = F.a->ws; const float* AFF = (const float*)(ws + WS_AFF); float* GATE = (float*)(ws + WS_GATE); int* SEL = (int*)(ws + WS_SEL); int* IDX = (int*)(ws + WS_IDX);
    LAS unsigned* hist = (LAS unsigned*)F.lds; LAS unsigned* wsum = hist + 256; LAS unsigned* bc = hist + 272;
    unsigned k[8]; { const u32x4* src = (const u32x4*)(AFF + ((size_t)b * NE + e) * S) + 2 * F.tid; const u32x4 a = src[0], c = src[1]; k[0] = a.x; k[1] = a.y; k[2] = a.z; k[3] = a.w; k[4] = c.x; k[5] = c.y; k[6] = c.z; k[7] = c.w; }
    unsigned prefix = 0u, need = CAP;
    for (int pass = 0; pass < 4; ++pass) { const int shift = 24 - 8 * pass;
        if (F.tid < 256) hist[F.tid] = 0u;
        __syncthreads();
#pragma unroll
        for (int i = 0; i < 8; ++i) if (pass == 0 || (k[i] >> (shift + 8)) == prefix) atomicAdd((unsigned*)&hist[(k[i] >> shift) & 255u], 1u);
        __syncthreads();
        if (F.wave == 0) { const unsigned c0 = hist[4 * F.lane], c1 = hist[4 * F.lane + 1], c2 = hist[4 * F.lane + 2], c3 = hist[4 * F.lane + 3]; const unsigned s = c0 + c1 + c2 + c3; unsigned suf = s;
#pragma unroll
            for (int o = 1; o < 64; o <<= 1) { const unsigned t = __shfl_down(suf, o); if (F.lane + o < 64) suf += t; }
            const unsigned above = suf - s;
            if (above < need && need <= suf) { unsigned run = above; int d;
                if (run + c3 >= need) d = 3; else { run += c3; if (run + c2 >= need) d = 2; else { run += c2; if (run + c1 >= need) d = 1; else { run += c1; d = 0; } } }
                bc[0] = (prefix << 8) | (unsigned)(4 * F.lane + d); bc[1] = need - run; } }
        __syncthreads();
        prefix = bc[0]; need = bc[1];
        __syncthreads();
    }
    const unsigned T = prefix;
    unsigned cg = 0u, ce = 0u;
#pragma unroll
    for (int i = 0; i < 8; ++i) { cg += k[i] > T ? 1u : 0u; ce += k[i] == T ? 1u : 0u; }
    unsigned pk = cg | (ce << 16), inc = pk;
#pragma unroll
    for (int o = 1; o < 64; o <<= 1) { const unsigned t = __shfl_up(inc, o); if (F.lane >= o) inc += t; }
    if (F.lane == 63) wsum[F.wave] = inc;
    __syncthreads();
    unsigned base = 0u;
#pragma unroll
    for (int w = 0; w < NWAVES; ++w) base += (w < F.wave) ? wsum[w] : 0u;
    unsigned run = base + inc - pk; unsigned G = run & 0xffffu, E = run >> 16;
#pragma unroll
    for (int i = 0; i < 8; ++i) { const bool gt = k[i] > T, eq = k[i] == T; const bool sel = gt || (eq && E < need); const unsigned slot = G + (E < need ? E : need);
        const int tok = b * S + 8 * F.tid + i;
        if (sel) { rows[slot] = tok; if ((int)(slot >> 8) == half) { const int r = (e * NB + b) * CAP + (int)slot; GATE[r] = __builtin_bit_cast(float, k[i]); IDX[r] = tok; } }
        if (half == 0) SEL[(size_t)tok * NE + e] = sel ? (int)slot : -1;
        G += gt ? 1u : 0u; E += eq ? 1u : 0u; }
    __syncthreads();
}
#ifndef PROBE_DUP
#define PROBE_DUP -1
#endif
#ifndef PROBE_SUB
#define PROBE_SUB 7
#endif
#ifndef PROBE_REPS
#define PROBE_REPS 1
#endif
namespace fa {
typedef float f32x16 __attribute__((ext_vector_type(16)));
typedef short s16x4 __attribute__((ext_vector_type(4)));
typedef short v4i16_t __attribute__((ext_vector_type(4)));
using pg8::bf16x8;
typedef LAS const char* lds_cptr;
constexpr int KOFF = 0, KSLOT_MAX = 12288, VOFF = 4 * KSLOT_MAX, VSLOT = 8192, WSOFF = VOFF + 4 * VSLOT, OSTOFF = WSOFF + 8 * 256, FA_LDS = OSTOFF + 8 * 4096;
static_assert(FA_LDS <= RING_BYTES, "attention LDS");
__device__ __forceinline__ int crow(int r, int hi) { return (r & 3) + 8 * (r >> 2) + 4 * hi; }
typedef float f32x2_t __attribute__((ext_vector_type(2))); typedef __bf16 bf16x2_t __attribute__((ext_vector_type(2)));
__device__ __forceinline__ unsigned cvtpk(float lo, float hi) { const f32x2_t v = {lo, hi}; const bf16x2_t b = __builtin_convertvector(v, bf16x2_t); return __builtin_bit_cast(unsigned, b); }
__device__ __forceinline__ s16x4 vtr(lds_cptr p) { return __builtin_bit_cast(s16x4, __builtin_amdgcn_ds_read_tr16_b64_v4i16((LAS v4i16_t*)p)); }
__device__ __forceinline__ float swap_max(float m) { auto rr = __builtin_amdgcn_permlane32_swap(__float_as_uint(m), __float_as_uint(m), false, false); return __builtin_fmaxf(__uint_as_float(rr[0]), __uint_as_float(rr[1])); }
__device__ __forceinline__ float swap_add(float m) { auto rr = __builtin_amdgcn_permlane32_swap(__float_as_uint(m), __float_as_uint(m), false, false); return __uint_as_float(rr[0]) + __uint_as_float(rr[1]); }
__device__ __forceinline__ void glds16(const void* base, unsigned voff, unsigned lds_dst) { unsigned keep;
    asm volatile("s_mov_b32 %0, m0\n\ts_mov_b32 m0, %3\n\ts_nop 0\n\tglobal_load_lds_dwordx4 %1, %2\n\ts_mov_b32 m0, %0" : "=&s"(keep) : "v"(voff), "s"(base), "s"(lds_dst) : "memory"); }
__device__ __forceinline__ unsigned lds_addr(LAS unsigned char* p) { return (unsigned)__builtin_amdgcn_readfirstlane((int)(unsigned)(size_t)p); }
#define FA_WAITV(N) asm volatile("s_waitcnt vmcnt(%0)" ::"n"(N) : "memory")
#define FA_BAR() asm volatile("s_waitcnt lgkmcnt(0)\n\ts_barrier" ::: "memory")
struct Src { const bf16* q; int ldq; const bf16* k0; int ldk0; const bf16* k1; int ldk1; const bf16* v; int ldv; bf16* o; };
template <int KS> __device__ __forceinline__ void qk_tile(f32x16& p0, f32x16& p1, lds_cptr kp, const bf16x8* qf, const f32x16& init) {
#pragma unroll
    for (int k = 0; k < KS; ++k) { const bf16x8 k0 = *(const LAS bf16x8*)(kp + k * 2048), k1 = *(const LAS bf16x8*)(kp + k * 2048 + 512);
        p0 = __builtin_amdgcn_mfma_f32_32x32x16_bf16(k0, qf[k], k == 0 ? init : p0, 0, 0, 0);
        p1 = __builtin_amdgcn_mfma_f32_32x32x16_bf16(k1, qf[k], k == 0 ? init : p1, 0, 0, 0); }
}
template <bool NEGM> __device__ __forceinline__ void sm_max(f32x16& p0, f32x16& p1, float& mhat, float& lsum, f32x16& o0, f32x16& o1, f32x16& negm, LAS float* wsf, bool first, bool live, int r32, int hi) {
    float ma = __builtin_fmaxf(p0[0], p1[0]), mb = __builtin_fmaxf(p0[1], p1[1]);
#pragma unroll
    for (int r = 2; r < 16; r += 2) { ma = __builtin_fmaxf(ma, __builtin_fmaxf(p0[r], p1[r])); mb = __builtin_fmaxf(mb, __builtin_fmaxf(p0[r + 1], p1[r + 1])); }
    const float rm = swap_max(__builtin_fmaxf(ma, mb));
    if (live && (first || __any(rm > 8.0f))) {
        const float dl = first ? rm : __builtin_fmaxf(rm, 0.f); mhat += dl;
#pragma unroll
        for (int r = 0; r < 16; ++r) { p0[r] -= dl; p1[r] -= dl; if constexpr (NEGM) negm[r] = -mhat; }
        if (!first) { const float f = __builtin_amdgcn_exp2f(-dl); lsum *= f; if (hi == 0) wsf[r32] = f;
#pragma unroll
            for (int r = 0; r < 16; ++r) { const float fr = wsf[crow(r, hi)]; o0[r] *= fr; o1[r] *= fr; } }
    }
}
template <int KS, bool SPLIT>
__device__ __forceinline__ void unit1(const Src& s, int q0, float lam, float eps, LAS unsigned char* lds, int tid) {
    constexpr int NPC = SPLIT ? 8 : 2 * KS, KSLOT = NPC * 1024, OPS = NPC > 8 ? 3 : 2, NT = S / 64, NKF = KS < 3 ? 2 * KS : 6;
    constexpr int NSL = SPLIT ? 8 : 6, LEAD = NSL - 3, KOFF = 0, VOFF = NSL * KSLOT, WSOFF = VOFF + NSL * VSLOT, OSTOFF = VOFF;
    static_assert(WSOFF + 2048 <= LDS_MISC && (!SPLIT || NSL * VSLOT >= 32768), "unit1 LDS");
    const int lane = tid & 63, r32 = lane & 31, hi = lane >> 5, wid = __builtin_amdgcn_readfirstlane(tid >> 6);
    const int grp = SPLIT ? (wid >> 2) : 0, qw = SPLIT ? (wid & 3) : wid;
    const unsigned koffA = (unsigned)(lane * s.ldk0 + wid * 8) * 2u, koffB = (unsigned)(lane * s.ldk1 + (wid & 3) * 8) * 2u;
    const unsigned voff = (unsigned)((16 * (wid & 3) + (lane >> 2)) * s.ldv + (wid >> 2) * 32 + (lane & 3) * 8) * 2u;
#define FA_DMA(t, slot) do { \
        glds16((const char*)s.k0 + (size_t)(t) * 128 * s.ldk0, koffA, lds_addr(lds + KOFF + (slot) * KSLOT + wid * 1024)); \
        if constexpr (NPC > 8) glds16((const char*)s.k1 + (size_t)(t) * 128 * s.ldk1, koffB, lds_addr(lds + KOFF + (slot) * KSLOT + (8 + (wid & 3)) * 1024)); \
        glds16((const char*)s.v + (size_t)(t) * 128 * s.ldv, voff, lds_addr(lds + VOFF + (slot) * VSLOT + wid * 1024)); } while (0)
    LAS float* wsf = (LAS float*)(lds + WSOFF) + wid * 64;
    FA_WAITV(0); FA_BAR();
    _Pragma("unroll") for (int i_ = 0; i_ < NSL - 1; ++i_) FA_DMA(i_, i_);
    bf16x8 qf[KS];
    { const bf16* qrow = s.q + (size_t)(q0 + qw * 32 + r32) * s.ldq + grp * (KS * 16) + hi * 8;
#pragma unroll
      for (int k = 0; k < KS; ++k) qf[k] = *(const bf16x8*)(qrow + 16 * k); }
    float mhat = 0.f, lsum = 0.f; f32x16 o0 = f32x16{}, o1 = f32x16{}, ol = f32x16{}, negm = f32x16{};
    const int kro = hi * 1024 + r32 * 16 + grp * (KS * 2048);
    const int vro = ((lane >> 4) & 1) * 32 + (lane & 3) * 8 + (4 * hi + ((lane & 15) >> 2)) * 64;
    const bf16x8 ones = (bf16x8){0x3F80, 0x3F80, 0x3F80, 0x3F80, 0x3F80, 0x3F80, 0x3F80, 0x3F80};
    f32x16 pA0, pA1, pB0, pB1;
    FA_WAITV((NSL - 3) * OPS); FA_BAR();
    qk_tile<KS>(pA0, pA1, (lds_cptr)(lds + KOFF + kro), qf, negm);
    sm_max<true>(pA0, pA1, mhat, lsum, o0, o1, negm, wsf, true, true, r32, hi);
    bf16x8 kf[NKF];
    { const lds_cptr kpn = (lds_cptr)(lds + KOFF + 1 * KSLOT + kro);
#pragma unroll
      for (int i = 0; i < NKF; ++i) kf[i] = *(const LAS bf16x8*)(kpn + (i >> 1) * 2048 + (i & 1) * 512); }
    int slot = 0;
#define SB() __builtin_amdgcn_sched_barrier(0)
#define EX(x) __builtin_amdgcn_exp2f(x)
#define EXx(P0_, P1_, i) do { f32x16& P_ = (i) < 8 ? P0_ : P1_; constexpr int b_ = (2 * (i)) & 15; P_[b_] = EX(P_[b_]); P_[b_ + 1] = EX(P_[b_ + 1]); } while (0)
#define CVx(P0_, P1_, i) do { f32x16& P_ = (i) < 8 ? P0_ : P1_; constexpr int b_ = (2 * (i)) & 15; pw[(i) >> 2][(i) & 3] = cvtpk(P_[b_], P_[b_ + 1]); } while (0)
#define MX3(d, a, b, c) asm("v_max3_f32 %0, %1, %2, %3" : "=v"(d) : "v"(a), "v"(b), "v"(c))
#define MXp(N0_, N1_, j) do { MX3(ma, ma, N0_[4 * (j)], N1_[4 * (j)]); MX3(mb, mb, N0_[4 * (j) + 1], N1_[4 * (j) + 1]); MX3(ma, ma, N0_[4 * (j) + 2], N1_[4 * (j) + 2]); MX3(mb, mb, N0_[4 * (j) + 3], N1_[4 * (j) + 3]); } while (0)
#define KLD(i, k, h) kf[i] = *(const LAS bf16x8*)(kpn + (k) * 2048 + (h) * 512)
#define KL2(i, k, h) kf[i] = *(const LAS bf16x8*)(kp2 + (k) * 2048 + (h) * 512)
#define VF(i) ((bf16x8){vlo[i][0], vlo[i][1], vlo[i][2], vlo[i][3], vhi[i][0], vhi[i][1], vhi[i][2], vhi[i][3]})
#define PW(k) __builtin_bit_cast(bf16x8, pw[k])
#define MF(A, B, C) __builtin_amdgcn_mfma_f32_32x32x16_bf16(A, B, C, 0, 0, 0)
#define FA_STEP(C0, C1, N0, N1) do { \
        FA_WAITV((NSL - 4) * OPS); FA_BAR(); \
        { const int tn = t + NSL - 1 < NT ? t + NSL - 1 : NT - 1; FA_DMA(tn, slot >= 1 ? slot - 1 : NSL - 1); } \
        const int sn = slot + 1 < NSL ? slot + 1 : 0, sn2 = sn + 1 < NSL ? sn + 1 : 0; const bool live = t + 1 < NT; \
        const lds_cptr kpn = (lds_cptr)(lds + KOFF + sn * KSLOT + kro), kp2 = (lds_cptr)(lds + KOFF + sn2 * KSLOT + kro); const lds_cptr vp = (lds_cptr)(lds + VOFF + slot * VSLOT + vro); \
        s16x4 vlo[8], vhi[8]; u32x4 pw[4]; float ma = -INFINITY, mb = -INFINITY; \
        _Pragma("unroll") for (int i = 0; i < 8; ++i) { vlo[i] = vtr(vp + (i >> 2) * 4096 + (i & 3) * 1024); vhi[i] = vtr(vp + (i >> 2) * 4096 + (i & 3) * 1024 + 512); } \
        SB(); __builtin_amdgcn_s_setprio(1); \
        if constexpr (KS == 2) { \
            EXx(C0, C1, 0); EXx(C0, C1, 1); EXx(C0, C1, 2); CVx(C0, C1, 0); CVx(C0, C1, 1); SB(); \
            N0 = MF(kf[0], qf[0], negm); EXx(C0, C1, 3); CVx(C0, C1, 2); SB(); \
            N1 = MF(kf[1], qf[0], negm); EXx(C0, C1, 4); CVx(C0, C1, 3); SB(); \
            N0 = MF(kf[2], qf[1], N0); EXx(C0, C1, 5); CVx(C0, C1, 4); SB(); \
            N1 = MF(kf[3], qf[1], N1); EXx(C0, C1, 6); CVx(C0, C1, 5); SB(); \
            o0 = MF(PW(0), VF(0), o0); EXx(C0, C1, 7); CVx(C0, C1, 6); SB(); \
            o1 = MF(PW(0), VF(4), o1); EXx(C0, C1, 8); CVx(C0, C1, 7); SB(); \
            ol = MF(PW(0), ones, ol); KL2(0, 0, 0); KL2(1, 0, 1); EXx(C0, C1, 9); CVx(C0, C1, 8); SB(); \
            o0 = MF(PW(1), VF(1), o0); KL2(2, 1, 0); KL2(3, 1, 1); EXx(C0, C1, 10); CVx(C0, C1, 9); SB(); \
            o1 = MF(PW(1), VF(5), o1); EXx(C0, C1, 11); CVx(C0, C1, 10); SB(); \
            ol = MF(PW(1), ones, ol); EXx(C0, C1, 12); CVx(C0, C1, 11); SB(); \
            o0 = MF(PW(2), VF(2), o0); EXx(C0, C1, 13); CVx(C0, C1, 12); SB(); \
            o1 = MF(PW(2), VF(6), o1); EXx(C0, C1, 14); CVx(C0, C1, 13); SB(); \
            ol = MF(PW(2), ones, ol); EXx(C0, C1, 15); CVx(C0, C1, 14); CVx(C0, C1, 15); SB(); \
            o0 = MF(PW(3), VF(3), o0); MXp(N0, N1, 0); SB(); \
            o1 = MF(PW(3), VF(7), o1); MXp(N0, N1, 1); SB(); \
            ol = MF(PW(3), ones, ol); MXp(N0, N1, 2); MXp(N0, N1, 3); SB(); \
        } else { \
            EXx(C0, C1, 0); EXx(C0, C1, 1); CVx(C0, C1, 0); SB(); \
            N0 = MF(kf[0], qf[0], negm); EXx(C0, C1, 2); CVx(C0, C1, 1); SB(); \
            N1 = MF(kf[1], qf[0], negm); KLD(0, 3, 0); KLD(1, 3, 1); EXx(C0, C1, 3); CVx(C0, C1, 2); SB(); \
            N0 = MF(kf[2], qf[1], N0); EXx(C0, C1, 4); CVx(C0, C1, 3); SB(); \
            N1 = MF(kf[3], qf[1], N1); KLD(2, 4, 0); KLD(3, 4, 1); EXx(C0, C1, 5); CVx(C0, C1, 4); SB(); \
            N0 = MF(kf[4], qf[2], N0); EXx(C0, C1, 6); CVx(C0, C1, 5); SB(); \
            N1 = MF(kf[5], qf[2], N1); KLD(4, 5, 0); KLD(5, 5, 1); EXx(C0, C1, 7); CVx(C0, C1, 6); SB(); \
            N0 = MF(kf[0], qf[3], N0); EXx(C0, C1, 8); CVx(C0, C1, 7); SB(); \
            N1 = MF(kf[1], qf[3], N1); EXx(C0, C1, 9); CVx(C0, C1, 8); SB(); \
            N0 = MF(kf[2], qf[4], N0); EXx(C0, C1, 10); CVx(C0, C1, 9); SB(); \
            N1 = MF(kf[3], qf[4], N1); EXx(C0, C1, 11); CVx(C0, C1, 10); SB(); \
            N0 = MF(kf[4], qf[5], N0); EXx(C0, C1, 12); CVx(C0, C1, 11); SB(); \
            N1 = MF(kf[5], qf[5], N1); EXx(C0, C1, 13); CVx(C0, C1, 12); SB(); \
            o0 = MF(PW(0), VF(0), o0); EXx(C0, C1, 14); CVx(C0, C1, 13); SB(); \
            o1 = MF(PW(0), VF(4), o1); EXx(C0, C1, 15); CVx(C0, C1, 14); SB(); \
            ol = MF(PW(0), ones, ol); CVx(C0, C1, 15); SB(); \
            o0 = MF(PW(1), VF(1), o0); KL2(0, 0, 0); KL2(1, 0, 1);  SB(); \
            o1 = MF(PW(1), VF(5), o1); KL2(2, 1, 0); KL2(3, 1, 1);  SB(); \
            ol = MF(PW(1), ones, ol); KL2(4, 2, 0); KL2(5, 2, 1);  SB(); \
            o0 = MF(PW(2), VF(2), o0); MXp(N0, N1, 0); SB(); \
            o1 = MF(PW(2), VF(6), o1); MXp(N0, N1, 1); SB(); \
            ol = MF(PW(2), ones, ol); MXp(N0, N1, 2); SB(); \
            o0 = MF(PW(3), VF(3), o0); MXp(N0, N1, 3); SB(); \
            o1 = MF(PW(3), VF(7), o1);  SB(); \
            ol = MF(PW(3), ones, ol);  SB(); \
        } \
        __builtin_amdgcn_s_setprio(0); \
          \
        { const float rm = swap_max(__builtin_fmaxf(ma, mb)); \
          if (live && __any(rm > 8.0f)) { \
              const float dl = __builtin_fmaxf(rm, 0.f); mhat += dl; \
              _Pragma("unroll") for (int r = 0; r < 16; ++r) { N0[r] -= dl; N1[r] -= dl; negm[r] = -mhat; } \
              const float f = __builtin_amdgcn_exp2f(-dl); if (hi == 0) wsf[r32] = f; \
              _Pragma("unroll") for (int r = 0; r < 16; ++r) { const float fr = wsf[crow(r, hi)]; o0[r] *= fr; o1[r] *= fr; ol[r] *= fr; } } } \
        slot = sn; } while (0)
    static_assert(KS == 2 || KS == 6, "unit1: schedules exist for KS = 2 and KS = 6");
#pragma unroll 1
    for (int t = 0; t < NT; t += 2) {
        FA_STEP(pA0, pA1, pB0, pB1);
        ++t; FA_STEP(pB0, pB1, pA0, pA1); --t;
    }
#undef FA_STEP
#undef SB
#undef EX
#undef EXx
#undef CVx
#undef MXp
#undef MX3
#undef KLD
#undef KL2
#undef VF
#undef PW
#undef MF
    f32x16 out[2];
#pragma unroll
    for (int r = 0; r < 16; ++r) { const float il = 1.0f / ol[r]; out[0][r] = o0[r] * il; out[1][r] = o1[r] * il; }
    FA_WAITV(0); FA_BAR();
    if constexpr (SPLIT) {
        LAS float* xch = (LAS float*)(lds + OSTOFF) + (size_t)qw * 2048;
        if (grp == 1) {
#pragma unroll
            for (int r = 0; r < 16; ++r) { xch[r * 64 + lane] = lam * out[0][r]; xch[(16 + r) * 64 + lane] = lam * out[1][r]; } }
        FA_BAR();
        if (grp == 1) return;
#pragma unroll
        for (int r = 0; r < 16; ++r) { out[0][r] -= xch[r * 64 + lane]; out[1][r] -= xch[(16 + r) * 64 + lane]; }
    }
    bf16* Ow = s.o + (size_t)(q0 + qw * 32) * D;
    LAS bf16* stg = (LAS bf16*)(lds + KOFF) + qw * 2048;
#pragma unroll
    for (int r = 0; r < 16; ++r) { float ss = out[0][r] * out[0][r] + out[1][r] * out[1][r];
        ss += __shfl_xor(ss, 1); ss += __shfl_xor(ss, 2); ss += __shfl_xor(ss, 4); ss += __shfl_xor(ss, 8); ss += __shfl_xor(ss, 16);
        const float rstd = 1.0f / sqrtf(ss * (1.0f / 64.0f) + eps); const int orow = crow(r, hi);
        stg[orow * 64 + r32] = (bf16)f2bf(out[0][r] * rstd); stg[orow * 64 + 32 + r32] = (bf16)f2bf(out[1][r] * rstd); }
#pragma unroll
    for (int i = 0; i < 4; ++i) { const int row = i * 8 + (lane >> 3), ch = lane & 7; const u32x4 v = *(const LAS u32x4*)(stg + row * 64 + ch * 8); *(u32x4*)(Ow + (size_t)row * D + ch * 8) = v; }
#undef FA_DMA
}
}

__device__ __forceinline__ void ph_attn_bc(Frame& F, int l) {
    unsigned char* ws = F.a->ws; const bf16* P = (const bf16*)(ws + WS_R1); const bf16* U = (const bf16*)(ws + WS_R2); bf16* O = (bf16*)(ws + WS_O);
    const float *lq1 = F.a->in[4] + l * 32, *lk1 = F.a->in[5] + l * 32, *lq2 = F.a->in[6] + l * 32, *lk2 = F.a->in[7] + l * 32;
    float d1 = 0.f, d2 = 0.f; for (int j = 0; j < 32; ++j) { d1 += lq1[j] * lk1[j]; d2 += lq2[j] * lk2[j]; }
    const float lam = expf(d1) - expf(d2) + (0.8f - 0.6f * expf(-0.3f * (float)l));
    if (F.a->sub & 2) {
    { const int xg = F.vcu >> 5, w = F.vcu & 31; const int nb = w < 20 ? 5 : 6, k0 = w < 20 ? w : 100 + (w - 20), ks = w < 20 ? 20 : 10;
#pragma unroll 1
    for (int i = 0; i < nb; ++i) { const int k = k0 + ks * i, bh = xg + 8 * (k >> 5), qb = k & 31, b = bh / 5, h = bh % 5; const bf16* pb = P + (size_t)b * S * NINP;
        fa::Src sr{pb + COL_BQ + h * 64, NINP, pb + COL_BK + h * 64, NINP, pb + COL_BK + h * 64, NINP, pb + COL_BV + h * 64, NINP, O + (size_t)b * S * D + 384 + h * 64};
        fa::unit1<2, true>(sr, qb * 128, lam, 1e-5f, F.lds, F.tid); } }
    }
    asm volatile("s_waitcnt vmcnt(0) lgkmcnt(0)\n\ts_barrier" ::: "memory");
    if (F.a->sub & 4) { const int xg = F.vcu >> 5, w = F.vcu & 31; const int nc = w < 20 ? 3 : 2, k0 = w < 20 ? w : 60 + (w - 20), ks = w < 20 ? 20 : 10;
#pragma unroll 1
    for (int i = 0; i < nc; ++i) { const int k = k0 + ks * i, bh = xg + 8 * (k >> 4), qb = k & 15, b = bh / 5, h = bh % 5; const bf16* ub = U + (size_t)b * S * NUP;
        fa::Src sr{ub + h * 96, NUP, ub + UCOL_KV + h * 128, NUP, P + (size_t)b * S * NINP + COL_CKR, NINP, ub + UCOL_KV + h * 128 + 64, NUP, O + (size_t)b * S * D + 704 + h * 64};
        fa::unit1<6, false>(sr, qb * 256, 0.f, 1e-6f, F.lds, F.tid); } }
    asm volatile("s_waitcnt vmcnt(0) lgkmcnt(0)\n\ts_barrier" ::: "memory");
}
namespace fa {
constexpr int AK_CH = 384 * 16, AV_DH = 384 * 64, AKOFF = 0, AVOFF = 8 * AK_CH, AWSOFF = AVOFF + 2 * AV_DH, ASTOFF = AWSOFF + 2048;
static_assert(ASTOFF + 8 * 4096 <= LDS_MISC, "A-pattern LDS");
struct AUnit { const bf16* Pb; int h, sh, c, U0, L; size_t rowbase; };
__device__ __forceinline__ AUnit aunit_decode(const bf16* P, int u) { const int bh = u / 48, rem = u % 48, pat = rem >> 4, blk = rem & 15, b = bh / 6, bpc = 16 >> (2 * pat);
    AUnit a; a.Pb = P + (size_t)b * S * NINP; a.h = bh % 6; a.sh = 2 * pat; a.c = blk / bpc; a.U0 = (blk % bpc) * 256; a.L = S >> a.sh; a.rowbase = (size_t)pat * M + (size_t)b * S; return a; }
__device__ __forceinline__ void aunit_dma(const AUnit& a, LAS unsigned char* lds, int wid, int lane) {
#pragma unroll
    for (int j = 0; j < 6; ++j) { const int pid = wid + 8 * j, ch = pid / 6, rg = pid % 6; int u = a.U0 - 64 + 64 * rg + lane; u = u < 0 ? 0 : (u >= a.L ? a.L - 1 : u);
        glds16(a.Pb, (unsigned)((a.c + (u << a.sh)) * NINP + COL_AK + a.h * 64 + ch * 8) * 2u, lds_addr(lds + AKOFF + ch * AK_CH + rg * 1024)); }
#pragma unroll
    for (int j = 0; j < 6; ++j) { const int pid = wid + 8 * j, dh = pid / 24, rg = pid % 24; int u = a.U0 - 64 + 16 * rg + (lane >> 2); u = u < 0 ? 0 : (u >= a.L ? a.L - 1 : u);
        glds16(a.Pb, (unsigned)((a.c + (u << a.sh)) * NINP + COL_AV + a.h * 64 + dh * 32 + (lane & 3) * 8) * 2u, lds_addr(lds + AVOFF + dh * AV_DH + rg * 1024)); }
}
}
__device__ __forceinline__ void ph_apat(Frame& F) {
    using namespace fa;
    unsigned char* ws = F.a->ws; const bf16* P = (const bf16*)(ws + WS_R1); bf16* PO = (bf16*)(ws + WS_AP); float* PM = (float*)(ws + WS_AP + AP_PO_BYTES); float* PL = (float*)(ws + WS_AP + AP_PO_BYTES + AP_ML_BYTES);
    LAS unsigned char* lds = F.lds; const int tid = F.tid, lane = tid & 63, r32 = lane & 31, hi = lane >> 5, wid = __builtin_amdgcn_readfirstlane(tid >> 6);
    const int e = F.vcu >> 1, u0 = e * 18 + ((F.vcu & 1) ? 8 : 0), n = (F.vcu & 1) ? 10 : 8;
    LAS float* wsf = (LAS float*)(lds + AWSOFF) + wid * 64; LAS bf16* stg = (LAS bf16*)(lds + ASTOFF) + wid * 2048;
    const int vro = ((lane >> 4) & 1) * 32 + (lane & 3) * 8 + (4 * hi + ((lane & 15) >> 2)) * 64;
    const bf16x8 ones = (bf16x8){0x3F80, 0x3F80, 0x3F80, 0x3F80, 0x3F80, 0x3F80, 0x3F80, 0x3F80};
    FA_WAITV(0); FA_BAR();
    AUnit a = aunit_decode(P, u0); aunit_dma(a, lds, wid, lane);
    AUnit prev = a; int prev_uq = 0; float pm_keep = 0.f; f32x16 pl_keep = f32x16{};
#define APAT_FLUSH() do { \
        if (hi == 0) PM[(prev.rowbase + (size_t)(prev.c + (prev_uq << prev.sh))) * 6 + prev.h] = pm_keep; \
        if (r32 == 0) { _Pragma("unroll") for (int r = 0; r < 16; ++r) PL[(prev.rowbase + (size_t)(prev.c + ((prev.U0 + 32 * wid + crow(r, hi)) << prev.sh))) * 6 + prev.h] = pl_keep[r]; } \
        _Pragma("unroll") for (int q = 0; q < 4; ++q) { const int row = q * 8 + (lane >> 3), ch = lane & 7; const u32x4 v = *(const LAS u32x4*)(stg + row * 64 + ch * 8); \
            const size_t t = prev.rowbase + (size_t)(prev.c + ((prev.U0 + 32 * wid + row) << prev.sh)); *(u32x4*)(PO + (t * 6 + prev.h) * 64 + ch * 8) = v; } } while (0)
    bf16x8 qf[4];
    { const bf16* qrow = a.Pb + (size_t)(a.c + ((a.U0 + 32 * wid + r32) << a.sh)) * NINP + COL_AQ + a.h * 64 + hi * 8;
#pragma unroll
      for (int k = 0; k < 4; ++k) qf[k] = *(const bf16x8*)(qrow + 16 * k); }
#pragma unroll 1
    for (int i = 0; i < n; ++i) {
        FA_WAITV(0); FA_BAR();
        if (i > 0) APAT_FLUSH();
        const int uq = a.U0 + 32 * wid + r32, L = a.L;
        float m = -1e30f; f32x16 o0 = f32x16{}, o1 = f32x16{}, ol = f32x16{};
#pragma unroll
        for (int j = 0; j < 3; ++j) {
            const int st0 = wid + 2 * j, st1 = st0 + 1;
            const lds_cptr kp0 = (lds_cptr)(lds + AKOFF + hi * AK_CH + (32 * st0 + r32) * 16), kp1 = kp0 + 512;
            f32x16 p0 = f32x16{}, p1 = f32x16{};
#pragma unroll
            for (int k = 0; k < 4; ++k) { p0 = __builtin_amdgcn_mfma_f32_32x32x16_bf16(*(const LAS bf16x8*)(kp0 + 2 * k * AK_CH), qf[k], p0, 0, 0, 0);
                if (j < 2) p1 = __builtin_amdgcn_mfma_f32_32x32x16_bf16(*(const LAS bf16x8*)(kp1 + 2 * k * AK_CH), qf[k], p1, 0, 0, 0); }
            float rm = -INFINITY;
#pragma unroll
            for (int r = 0; r < 16; ++r) { const int d0 = 64 * j - 64 + crow(r, hi) - r32, k0 = uq + d0; const bool ok0 = d0 >= -64 && d0 <= 64 && k0 >= 0 && k0 < L; p0[r] = ok0 ? p0[r] : -INFINITY; rm = __builtin_fmaxf(rm, p0[r]);
                if (j < 2) { const int d1 = d0 + 32, k1 = uq + d1; const bool ok1 = d1 >= -64 && d1 <= 64 && k1 >= 0 && k1 < L; p1[r] = ok1 ? p1[r] : -INFINITY; rm = __builtin_fmaxf(rm, p1[r]); } }
            rm = swap_max(rm);
            if (__any(rm > m + 8.0f)) {
                const float mn = __builtin_fmaxf(m, rm), f = __builtin_amdgcn_exp2f(m - mn); m = mn; if (hi == 0) wsf[r32] = f;
#pragma unroll
                for (int r = 0; r < 16; ++r) { const float fr = wsf[crow(r, hi)]; o0[r] *= fr; o1[r] *= fr; ol[r] *= fr; } }
            u32x4 pw[4];
#pragma unroll
            for (int q = 0; q < 4; ++q) { pw[0][q] = cvtpk(__builtin_amdgcn_exp2f(p0[2 * q] - m), __builtin_amdgcn_exp2f(p0[2 * q + 1] - m)); pw[1][q] = cvtpk(__builtin_amdgcn_exp2f(p0[8 + 2 * q] - m), __builtin_amdgcn_exp2f(p0[9 + 2 * q] - m));
                if (j < 2) { pw[2][q] = cvtpk(__builtin_amdgcn_exp2f(p1[2 * q] - m), __builtin_amdgcn_exp2f(p1[2 * q + 1] - m)); pw[3][q] = cvtpk(__builtin_amdgcn_exp2f(p1[8 + 2 * q] - m), __builtin_amdgcn_exp2f(p1[9 + 2 * q] - m)); } }
            const lds_cptr vp = (lds_cptr)(lds + AVOFF + 32 * st0 * 64 + vro);
#pragma unroll
            for (int kk = 0; kk < (j < 2 ? 4 : 2); ++kk) { const bf16x8 pa = __builtin_bit_cast(bf16x8, pw[kk]);
                const s16x4 l0 = vtr(vp + kk * 1024), h0 = vtr(vp + kk * 1024 + 512), l1 = vtr(vp + AV_DH + kk * 1024), h1 = vtr(vp + AV_DH + kk * 1024 + 512);
                o0 = __builtin_amdgcn_mfma_f32_32x32x16_bf16(pa, (bf16x8){l0[0], l0[1], l0[2], l0[3], h0[0], h0[1], h0[2], h0[3]}, o0, 0, 0, 0);
                o1 = __builtin_amdgcn_mfma_f32_32x32x16_bf16(pa, (bf16x8){l1[0], l1[1], l1[2], l1[3], h1[0], h1[1], h1[2], h1[3]}, o1, 0, 0, 0);
                ol = __builtin_amdgcn_mfma_f32_32x32x16_bf16(pa, ones, ol, 0, 0, 0); }
        }
        FA_BAR();
        const AUnit cur = a;
        if (i + 1 < n) { a = aunit_decode(P, u0 + i + 1); aunit_dma(a, lds, wid, lane); }
        pm_keep = m; pl_keep = ol; prev = cur; prev_uq = uq;
#pragma unroll
        for (int r = 0; r < 16; ++r) { const float il = 1.0f / ol[r]; const int orow = crow(r, hi);
            stg[orow * 64 + r32] = (bf16)f2bf(o0[r] * il); stg[orow * 64 + 32 + r32] = (bf16)f2bf(o1[r] * il); }
        if (i + 1 < n) { const bf16* qrow = a.Pb + (size_t)(a.c + ((a.U0 + 32 * wid + r32) << a.sh)) * NINP + COL_AQ + a.h * 64 + hi * 8;
#pragma unroll
            for (int k = 0; k < 4; ++k) qf[k] = *(const bf16x8*)(qrow + 16 * k); }
    }
    APAT_FLUSH();
#undef APAT_FLUSH
    asm volatile("s_waitcnt vmcnt(0) lgkmcnt(0)\n\ts_barrier" ::: "memory");
}
namespace fa {
constexpr int A2K_CH = 256 * 16, A2V_DH = 256 * 64, A2HALF = 65536;
__device__ __forceinline__ AUnit aunit2_decode(const bf16* P, int u) { const int bh = u / 96, rem = u % 96, pat = rem >> 5, blk = rem & 31, b = bh / 6, bpc = 32 >> (2 * pat);
    AUnit a; a.Pb = P + (size_t)b * S * NINP; a.h = bh % 6; a.sh = 2 * pat; a.c = blk / bpc; a.U0 = (blk % bpc) * 128; a.L = S >> a.sh; a.rowbase = (size_t)pat * M + (size_t)b * S; return a; }
__device__ __forceinline__ void aunit2_dma(const AUnit& a, LAS unsigned char* hb, int w4, int lane) {
#pragma unroll
    for (int j = 0; j < 8; ++j) { const int pid = w4 + 4 * j, ch = pid >> 2, rg = pid & 3; int u = a.U0 - 64 + 64 * rg + lane; u = u < 0 ? 0 : (u >= a.L ? a.L - 1 : u);
        glds16(a.Pb, (unsigned)((a.c + (u << a.sh)) * NINP + COL_AK + a.h * 64 + ch * 8) * 2u, lds_addr(hb + ch * A2K_CH + rg * 1024)); }
#pragma unroll
    for (int j = 0; j < 8; ++j) { const int pid = w4 + 4 * j, dh = pid >> 4, rg = pid & 15; int u = a.U0 - 64 + 16 * rg + (lane >> 2); u = u < 0 ? 0 : (u >= a.L ? a.L - 1 : u);
        glds16(a.Pb, (unsigned)((a.c + (u << a.sh)) * NINP + COL_AV + a.h * 64 + dh * 32 + (lane & 3) * 8) * 2u, lds_addr(hb + 32768 + dh * A2V_DH + rg * 1024)); }
}
__device__ __forceinline__ void half_bar(volatile LAS unsigned* cnt, unsigned& gen, int lane) {
    asm volatile("s_waitcnt lgkmcnt(0)" ::: "memory"); ++gen;
    if (lane == 0) __hip_atomic_fetch_add((LAS unsigned*)cnt, 1u, __ATOMIC_RELAXED, __HIP_MEMORY_SCOPE_WORKGROUP);
    for (unsigned sp = 0; *cnt < 4u * gen; ++sp) { __builtin_amdgcn_s_sleep(1); if (sp > (1u << 22)) break; }
    asm volatile("" ::: "memory");
}
}
__device__ __forceinline__ void ph_apat2(Frame& F, volatile LAS unsigned* MISC) {
    using namespace fa;
    unsigned char* ws = F.a->ws; const bf16* P = (const bf16*)(ws + WS_R1); bf16* PO = (bf16*)(ws + WS_AP); float* PM = (float*)(ws + WS_AP + AP_PO_BYTES); float* PL = (float*)(ws + WS_AP + AP_PO_BYTES + AP_ML_BYTES);
    const int tid = F.tid, lane = tid & 63, r32 = lane & 31, hi = lane >> 5, wid = __builtin_amdgcn_readfirstlane(tid >> 6), half = wid >> 2, w4 = wid & 3;
    LAS unsigned char* hb = F.lds + half * A2HALF;
    LAS float* wsf = (LAS float*)(F.lds + LDS_AP2 + 8 * 2048) + wid * 64; LAS bf16* stg = (LAS bf16*)(F.lds + LDS_AP2) + wid * 1024;
    volatile LAS unsigned* cnt = MISC + 8 + half; unsigned gen = 0u;
    const int e = F.vcu >> 1, odd = F.vcu & 1, n = odd ? 10 : 8, u0 = e * 36 + (odd ? 16 + 10 * half : 8 * half);
    const int vro = ((lane >> 4) & 1) * 32 + (lane & 3) * 8 + (4 * hi + ((lane & 15) >> 2)) * 64;
    const bf16x8 ones = (bf16x8){0x3F80, 0x3F80, 0x3F80, 0x3F80, 0x3F80, 0x3F80, 0x3F80, 0x3F80};
    if (tid == 0) { MISC[8] = 0u; MISC[9] = 0u; }
    asm volatile("s_waitcnt vmcnt(0) lgkmcnt(0)\n\ts_barrier" ::: "memory");
    AUnit a = aunit2_decode(P, u0); aunit2_dma(a, hb, w4, lane);
    bf16x8 qf[4];
    { const bf16* qrow = a.Pb + (size_t)(a.c + ((a.U0 + 32 * w4 + r32) << a.sh)) * NINP + COL_AQ + a.h * 64 + hi * 8;
#pragma unroll
      for (int k = 0; k < 4; ++k) qf[k] = *(const bf16x8*)(qrow + 16 * k); }
#pragma unroll 1
    for (int i = 0; i < n; ++i) {
        FA_WAITV(0); half_bar(cnt, gen, lane);
        const int uq = a.U0 + 32 * w4 + r32, L = a.L; const bool edge = a.U0 < 64 || a.U0 + 192 > L;
        float m = -1e30f; f32x16 o0 = f32x16{}, o1 = f32x16{}, ol = f32x16{};
#pragma unroll
        for (int j = 0; j < 3; ++j) {
            const int st0 = w4 + 2 * j;
            const lds_cptr kp0 = (lds_cptr)(hb + hi * A2K_CH + (32 * st0 + r32) * 16), kp1 = kp0 + 512;
            f32x16 p0 = f32x16{}, p1 = f32x16{};
#pragma unroll
            for (int k = 0; k < 4; ++k) { p0 = __builtin_amdgcn_mfma_f32_32x32x16_bf16(*(const LAS bf16x8*)(kp0 + 2 * k * A2K_CH), qf[k], p0, 0, 0, 0);
                if (j < 2) p1 = __builtin_amdgcn_mfma_f32_32x32x16_bf16(*(const LAS bf16x8*)(kp1 + 2 * k * A2K_CH), qf[k], p1, 0, 0, 0); }
            float rm = -INFINITY;
            if (edge) {
#pragma unroll
                for (int r = 0; r < 16; ++r) { const int d0 = 64 * j - 64 + crow(r, hi) - r32, k0 = uq + d0; const bool ok0 = d0 >= -64 && d0 <= 64 && k0 >= 0 && k0 < L; p0[r] = ok0 ? p0[r] : -INFINITY; rm = __builtin_fmaxf(rm, p0[r]);
                    if (j < 2) { const int d1 = d0 + 32, k1 = uq + d1; const bool ok1 = d1 >= -64 && d1 <= 64 && k1 >= 0 && k1 < L; p1[r] = ok1 ? p1[r] : -INFINITY; rm = __builtin_fmaxf(rm, p1[r]); } }
            } else {
#pragma unroll
                for (int r = 0; r < 16; ++r) { if (j == 0) p0[r] = crow(r, hi) >= r32 ? p0[r] : -INFINITY; if (j == 2) p0[r] = crow(r, hi) <= r32 ? p0[r] : -INFINITY;
                    rm = __builtin_fmaxf(rm, p0[r]); if (j < 2) rm = __builtin_fmaxf(rm, p1[r]); }
            }
            rm = swap_max(rm);
            if (__any(rm > m + 8.0f)) {
                const float mn = __builtin_fmaxf(m, rm), f = __builtin_amdgcn_exp2f(m - mn); m = mn; if (hi == 0) wsf[r32] = f;
#pragma unroll
                for (int r = 0; r < 16; ++r) { const float fr = wsf[crow(r, hi)]; o0[r] *= fr; o1[r] *= fr; ol[r] *= fr; } }
            u32x4 pw[4];
#pragma unroll
            for (int q = 0; q < 4; ++q) { pw[0][q] = cvtpk(__builtin_amdgcn_exp2f(p0[2 * q] - m), __builtin_amdgcn_exp2f(p0[2 * q + 1] - m)); pw[1][q] = cvtpk(__builtin_amdgcn_exp2f(p0[8 + 2 * q] - m), __builtin_amdgcn_exp2f(p0[9 + 2 * q] - m));
                if (j < 2) { pw[2][q] = cvtpk(__builtin_amdgcn_exp2f(p1[2 * q] - m), __builtin_amdgcn_exp2f(p1[2 * q + 1] - m)); pw[3][q] = cvtpk(__builtin_amdgcn_exp2f(p1[8 + 2 * q] - m), __builtin_amdgcn_exp2f(p1[9 + 2 * q] - m)); } }
            const lds_cptr vp = (lds_cptr)(hb + 32768 + 32 * st0 * 64 + vro);
#pragma unroll
            for (int kk = 0; kk < (j < 2 ? 4 : 2); ++kk) { const bf16x8 pa = __builtin_bit_cast(bf16x8, pw[kk]);
                const s16x4 l0 = vtr(vp + kk * 1024), h0 = vtr(vp + kk * 1024 + 512), l1 = vtr(vp + A2V_DH + kk * 1024), h1 = vtr(vp + A2V_DH + kk * 1024 + 512);
                o0 = __builtin_amdgcn_mfma_f32_32x32x16_bf16(pa, (bf16x8){l0[0], l0[1], l0[2], l0[3], h0[0], h0[1], h0[2], h0[3]}, o0, 0, 0, 0);
                o1 = __builtin_amdgcn_mfma_f32_32x32x16_bf16(pa, (bf16x8){l1[0], l1[1], l1[2], l1[3], h1[0], h1[1], h1[2], h1[3]}, o1, 0, 0, 0);
                ol = __builtin_amdgcn_mfma_f32_32x32x16_bf16(pa, ones, ol, 0, 0, 0); }
        }
        half_bar(cnt, gen, lane);
        const AUnit cur = a;
        if (i + 1 < n) { a = aunit2_decode(P, u0 + i + 1); aunit2_dma(a, hb, w4, lane); }
        if (hi == 0) PM[(cur.rowbase + (size_t)(cur.c + (uq << cur.sh))) * 6 + cur.h] = m;
        if (r32 == 0) {
#pragma unroll
            for (int r = 0; r < 16; ++r) PL[(cur.rowbase + (size_t)(cur.c + ((cur.U0 + 32 * w4 + crow(r, hi)) << cur.sh))) * 6 + cur.h] = ol[r]; }
#pragma unroll
        for (int ps = 0; ps < 2; ++ps) {
#pragma unroll
            for (int r = 0; r < 16; ++r) if ((crow(r, 0) >> 4) == ps) { const float il = 1.0f / ol[r]; const int orow = crow(r, hi) & 15;
                stg[orow * 64 + r32] = (bf16)f2bf(o0[r] * il); stg[orow * 64 + 32 + r32] = (bf16)f2bf(o1[r] * il); }
#pragma unroll
            for (int q = 0; q < 2; ++q) { const int row = q * 8 + (lane >> 3), ch = lane & 7; const u32x4 v = *(const LAS u32x4*)(stg + row * 64 + ch * 8);
                const size_t t = cur.rowbase + (size_t)(cur.c + ((cur.U0 + 32 * w4 + 16 * ps + row) << cur.sh)); *(u32x4*)(PO + (t * 6 + cur.h) * 64 + ch * 8) = v; }
        }
        if (i + 1 < n) { const bf16* qrow = a.Pb + (size_t)(a.c + ((a.U0 + 32 * w4 + r32) << a.sh)) * NINP + COL_AQ + a.h * 64 + hi * 8;
#pragma unroll
            for (int k = 0; k < 4; ++k) qf[k] = *(const bf16x8*)(qrow + 16 * k); }
    }
    asm volatile("s_waitcnt vmcnt(0) lgkmcnt(0)\n\ts_barrier" ::: "memory");
}
__device__ __forceinline__ void ph_acomb(Frame& F) {
    unsigned char* ws = F.a->ws; const bf16* PO = (const bf16*)(ws + WS_AP); const float* PM = (const float*)(ws + WS_AP + AP_PO_BYTES); const float* PL = (const float*)(ws + WS_AP + AP_PO_BYTES + AP_ML_BYTES); bf16* O = (bf16*)(ws + WS_O);
#pragma unroll 2
    for (int i = blockIdx.x * NTHR + F.tid; i < M * 6 * 8; i += GRID * NTHR) { const int th = i >> 3, ch = i & 7, t = th / 6, h = th % 6;
        float mm[3], ll[3], mx = -1e30f;
#pragma unroll
        for (int p = 0; p < 3; ++p) { mm[p] = PM[((size_t)p * M + t) * 6 + h]; ll[p] = PL[((size_t)p * M + t) * 6 + h]; mx = fmaxf(mx, mm[p]); }
        float den = 0.f, acc[8];
#pragma unroll
        for (int j = 0; j < 8; ++j) acc[j] = 0.f;
#pragma unroll
        for (int p = 0; p < 3; ++p) { const float w = exp2f(mm[p] - mx) * ll[p]; den += w; float v[8]; ld8(PO + (((size_t)p * M + t) * 6 + h) * 64 + ch * 8, v);
#pragma unroll
            for (int j = 0; j < 8; ++j) acc[j] += w * v[j]; }
        const float id = 1.0f / den; float ss = 0.f;
#pragma unroll
        for (int j = 0; j < 8; ++j) { acc[j] *= id; ss += acc[j] * acc[j]; }
        ss += __shfl_xor(ss, 1); ss += __shfl_xor(ss, 2); ss += __shfl_xor(ss, 4);
        const float rstd = 1.0f / sqrtf(ss * (1.0f / 64.0f) + 1e-6f);
#pragma unroll
        for (int j = 0; j < 8; ++j) acc[j] *= rstd;
        store8(O + (size_t)t * D + h * 64 + ch * 8, acc); }
}
#ifndef MK_SPLIT
#define MK_SPLIT 0
#endif
__global__ void __launch_bounds__(NTHR, 2) mk_fwd(Args args) {
    extern __shared__ __attribute__((aligned(16))) unsigned char lds_raw[];
    Frame F; F.lds = (LAS unsigned char*)lds_raw; F.tid = threadIdx.x; F.lane = F.tid & 63; F.wave = __builtin_amdgcn_readfirstlane(F.tid >> 6);
    { const int bx = blockIdx.x; F.vcu = (bx % 8) * (GRID / 8) + bx / 8; } F.gw = F.vcu * NWAVES + F.wave; F.a = (CArgs*)__builtin_amdgcn_kernarg_segment_ptr();
    volatile LAS unsigned* MISC = (volatile LAS unsigned*)(F.lds + LDS_MISC);
    if (F.tid < 32) MISC[F.tid] = 0u;
    __syncthreads();
#if !MK_SPLIT
    XcdBarrier bar = xcd_barrier_post((unsigned*)(args.ws + WS_CTL) + CW_BAR, MISC);
#define GRID_BAR() do { PH_BEGIN(); xcd_barrier(bar, F.tid); } while (0)
#else
#define GRID_BAR() do {} while (0)
#endif
    const int lo = args.ph_lo, hi = args.ph_hi;
#define IN(k) (lo <= (k) && (k) < hi)
#define PH_BEGIN() do { int t_ = (int)__builtin_amdgcn_mbcnt_hi(~0u, __builtin_amdgcn_mbcnt_lo(~0u, 0u)); int w_ = F.wave; CArgs* a_ = (CArgs*)__builtin_amdgcn_kernarg_segment_ptr(); asm volatile("" : "+v"(t_), "+s"(w_), "+s"(a_)); F.wave = w_; F.lane = t_; F.tid = w_ * 64 + t_; F.a = a_; } while (0)
#define SEAM(k) do { if (IN(k) && IN((k) + 1)) GRID_BAR(); } while (0)
    LAS int* rows = (LAS int*)(F.lds + LDS_ROWS); LAS float* rs = (LAS float*)(F.lds + LDS_RS);
#define ws (F.a->ws)
#define XN ((bf16*)(ws + WS_X))
#define P ((bf16*)(ws + WS_R1))
#define ACT ((bf16*)(ws + WS_R1))
#define U ((bf16*)(ws + WS_R2))
#define O ((bf16*)(ws + WS_O))
#define Y ((bf16*)(ws + WS_R2))
#define TAB ((const float*)(ws + WS_TAB))
    for (int l = 0; l < DEPTH; ++l) {
        const int pb = 8 * l;
        if (IN(pb + 0)) { PH_BEGIN(); if (l == 0) ph_tab(F); if (F.a->sub & 1) ph_wconv(F, l, 0, F.gw, GRID * NWAVES); if (F.a->sub & 2) ph_entry(F, l == 0 ? 0 : 1); }
        SEAM(pb + 0);
        if (IN(pb + 1)) { PH_BEGIN(); pg8::Gemm g{XN, (const bf16*)(ws + WS_WIN), D, D, D}; pg8::PanelOrder<false> Sd{F.vcu >> 1, 5 * (F.vcu & 1), 5, (size_t)256 * D * 2, (size_t)256 * D * 2, 0, nullptr};
            pg8::EpiIn E{P, TAB, (const float*)(ws + WS_RSTDA)}; pg8::gemm_phase<pg8::EpiIn, pg8::PanelOrder<false>, false>(F.lds, g, Sd, E, F.tid); }
        SEAM(pb + 1);
        if (IN(pb + 2)) { PH_BEGIN(); const int pm = F.vcu >> 1; if (F.a->sub & 1) {
            { const int r = F.tid >> 1, part = F.tid & 1; const bf16* pr = P + (size_t)(pm * 256 + r) * NINP + (part ? COL_CKV : COL_CQ); const int nch = part ? 16 : 24; float s = 0.f;
#pragma unroll 1
                for (int c0 = 0; c0 < nch; c0 += 8) { u32x4 w[8];
#pragma unroll
                    for (int c = 0; c < 8; ++c) w[c] = *(const u32x4*)(pr + 8 * (c0 + c));
#pragma unroll
                    for (int c = 0; c < 8; ++c) { const float a0 = bf2f(w[c].x & 0xffffu), a1 = bf2f(w[c].x >> 16), a2 = bf2f(w[c].y & 0xffffu), a3 = bf2f(w[c].y >> 16), a4 = bf2f(w[c].z & 0xffffu), a5 = bf2f(w[c].z >> 16), a6 = bf2f(w[c].w & 0xffffu), a7 = bf2f(w[c].w >> 16);
                        s += (a0 * a0 + a1 * a1) + (a2 * a2 + a3 * a3) + (a4 * a4 + a5 * a5) + (a6 * a6 + a7 * a7); } }
                rs[2 * r + part] = part ? 1.0f / sqrtf(s * (1.0f / 128.0f) + 1e-6f) : QS_C / sqrtf(s * (1.0f / 192.0f) + 1e-6f); }
            __syncthreads();
            pg8::Gemm g{P + COL_CQ, (const bf16*)(ws + WS_WUP), NINP, KUP, KUP}; pg8::PanelOrder<false> Sd{pm, (F.vcu & 1) ? 3 : 0, (F.vcu & 1) ? 2 : 3, (size_t)256 * NINP * 2, (size_t)256 * KUP * 2, 0, nullptr};
            pg8::EpiUp E{U, TAB, rs}; pg8::gemm_phase<pg8::EpiUp, pg8::PanelOrder<false>, true>(F.lds, g, Sd, E, F.tid); } if (F.a->sub & 2) { PH_BEGIN(); ph_apat2(F, MISC); } }
        SEAM(pb + 2);
        if (IN(pb + 3)) { if (F.a->sub & 1) { PH_BEGIN(); ph_acomb(F); } PH_BEGIN();
            if ((F.vcu & 31) >= 32 - NWC) { if (F.a->sub & 1) ph_wconv(F, l, 1, (((F.vcu >> 5) * NWC + (F.vcu & 31) - (32 - NWC)) * NWAVES) + F.wave, 8 * NWC * NWAVES); }
            else ph_attn_bc(F, l); }
        SEAM(pb + 3);
        if (IN(pb + 4)) { PH_BEGIN(); pg8::Gemm g{O, (const bf16*)(ws + WS_WOUT), D, D, D}; pg8::PanelOrder<false> Sd{F.vcu >> 1, 2 * (F.vcu & 1), 2, (size_t)256 * D * 2, (size_t)256 * D * 2, 0, nullptr};
            pg8::EpiOut E{XN, l == 0 ? F.a->in[0] : (const float*)nullptr}; pg8::gemm_phase<pg8::EpiOut, pg8::PanelOrder<false>, true>(F.lds, g, Sd, E, F.tid); }
        SEAM(pb + 4);
        if (IN(pb + 5)) { PH_BEGIN(); ph_router(F, l); }
        SEAM(pb + 5);
        if (IN(pb + 6)) { PH_BEGIN(); const int e = F.vcu >> 4, b = (F.vcu >> 1) & 7, half = F.vcu & 1;
            topk_select(F, b, e, half, rows);
            pg8::Gemm g{XN, (const bf16*)(ws + WS_WGU), D, D, D}; pg8::PairOrder<true> Sd{F.vcu & ~1, half, 11, 6, 0, (size_t)256 * D * 2, (size_t)e * NGU * D * 2, rows};
            pg8::EpiG1 E{ACT, (const float*)(ws + WS_RSTD), rows}; pg8::gemm_phase<pg8::EpiG1, pg8::PairOrder<true>, false>(F.lds, g, Sd, E, F.tid); }
        if (IN(pb + 6) && IN(pb + 7)) { PH_BEGIN(); asm volatile("s_waitcnt vmcnt(0)" ::: "memory"); __syncthreads();
            if (F.tid == 0) { unsigned* ctr = (unsigned*)(ws + WS_CTL) + CW_PAIR + 64 * (128 * l + (F.vcu >> 1)); unsigned* tmo = (unsigned*)(ws + WS_CTL) + CW_BAR;
                __builtin_amdgcn_fence(__ATOMIC_RELEASE, "agent"); asm volatile("s_waitcnt vmcnt(0)" ::: "memory");
                xb_add(ctr, 1u); XB_SPIN(xb_ld(ctr) < 2u, tmo);
                __builtin_amdgcn_fence(__ATOMIC_ACQUIRE, "agent"); asm volatile("s_waitcnt vmcnt(0)" ::: "memory"); }
            __syncthreads(); }
        if (IN(pb + 7)) { PH_BEGIN(); const int e = F.vcu >> 4;
            pg8::Gemm g{ACT, (const bf16*)(ws + WS_WD), FF, FF, FF}; pg8::PairOrder<false> Sd{F.vcu & ~1, F.vcu & 1, 4, 2, (size_t)256 * FF * 2, (size_t)256 * FF * 2, (size_t)e * D * FF * 2, nullptr};
            pg8::EpiBf16 E{Y, D}; pg8::gemm_phase<pg8::EpiBf16, pg8::PairOrder<false>, false>(F.lds, g, Sd, E, F.tid); }
        SEAM(pb + 7);
    }
    if (IN(8 * DEPTH)) { PH_BEGIN(); ph_entry(F, 2); }
#undef IN
#undef SEAM
#undef ws
#undef XN
#undef P
#undef ACT
#undef U
#undef O
#undef Y
#undef TAB
}

extern "C" void kernel_launch(void* const* d_in, const int* in_sizes, int n_in, void* d_out, int out_size, void* d_ws, size_t ws_size, hipStream_t stream) {
    static int ready = 0;
    if (ready == 0) {
        if (n_in != 22 || out_size != M * D || ws_size < WS_END) { fprintf(stderr, "kernel_launch: unexpected shapes (n_in %d out %d ws %zu)\n", n_in, out_size, ws_size); ready = -1; return; }
        int dev = 0, cus = 0, per_cu = 0; hipGetDevice(&dev); hipDeviceGetAttribute(&cus, hipDeviceAttributeMultiprocessorCount, dev);
        if (hipFuncSetAttribute((const void*)mk_fwd, hipFuncAttributeMaxDynamicSharedMemorySize, LDS_BYTES) != hipSuccess) { fprintf(stderr, "kernel_launch: hipFuncSetAttribute failed\n"); ready = -1; return; }
        hipOccupancyMaxActiveBlocksPerMultiprocessor(&per_cu, (const void*)mk_fwd, NTHR, LDS_BYTES); (void)hipGetLastError();
        if (cus < GRID || per_cu < 1) fprintf(stderr, "kernel_launch: note: %d CUs, occupancy %d; the grid is %d workgroups, one per CU\n", cus, per_cu, GRID);
        ready = 1;
    }
    if (ready < 0) return;
    hipMemsetAsync((char*)d_ws + WS_CTL, 0, CTL_BYTES, stream);
    Args a{}; for (int i = 0; i < 22; ++i) a.in[i] = (const float*)d_in[i];
    a.out = (float*)d_out; a.ws = (unsigned char*)d_ws;
    a.sub = 7;
#if MK_SPLIT
    for (int ph = 0; ph < NPHASE; ++ph) { a.ph_lo = ph; a.ph_hi = ph + 1; a.sub = 7; hipLaunchKernelGGL(mk_fwd, dim3(GRID), dim3(NTHR), LDS_BYTES, stream, a);
        if (PROBE_DUP >= 0 && ((ph < 8 * DEPTH && (ph & 7) == PROBE_DUP) || ph == PROBE_DUP)) { a.sub = PROBE_SUB; for (int r = 0; r < PROBE_REPS; ++r) hipLaunchKernelGGL(mk_fwd, dim3(GRID), dim3(NTHR), LDS_BYTES, stream, a); } }
#else
    a.ph_lo = 0; a.ph_hi = NPHASE; hipLaunchKernelGGL(mk_fwd, dim3(GRID), dim3(NTHR), LDS_BYTES, stream, a);
#endif
}
```

```cpp
#include <hip/hip_runtime.h>
#include <cstdio>
#include <cstdint>

typedef unsigned short bf16;
typedef float f32x4 __attribute__((ext_vector_type(4)));
typedef unsigned u32x4 __attribute__((ext_vector_type(4)));
typedef unsigned u32x2 __attribute__((ext_vector_type(2)));

constexpr int NB = 8, S = 4096, M = NB * S, D = 1024, DEPTH = 2;
constexpr int NIN = 2464, NINP = 2560;
constexpr int COL_AQ = 0, COL_AK = 384, COL_AV = 768, COL_BQ = 1152, COL_BK = 1472, COL_BV = 1792, COL_CQ = 2112, COL_CKV = 2304, COL_CKR = 2432;
constexpr int NUP = 1280, KUP = 384;
constexpr int UCOL_KV = 512;
constexpr int NE = 16, CAP = 512, FF = 1408, NGU = 2 * FF;
constexpr int MR = NE * NB * CAP;
constexpr int TABW = 56;
constexpr float LOG2E = 1.4426950408889634f;
constexpr float QS_A = 0.125f * LOG2E, QS_B = 0.17677669529663687f * LOG2E, QS_C = 0.10206207261596575f * LOG2E;

constexpr size_t MiB = 1u << 20;
constexpr size_t WS_CTL = 0, CTL_BYTES = 1 * MiB;
constexpr size_t WS_TAB = 1 * MiB;
constexpr size_t WS_AFF = 8 * MiB;
constexpr size_t WS_IDX = 10 * MiB;
constexpr size_t WS_GATE = 10 * MiB + 256 * 1024;
constexpr size_t WS_SEL = 10 * MiB + 512 * 1024;
constexpr size_t WS_RSTD = 13 * MiB;
constexpr size_t WS_RSTDA = 13 * MiB + 256 * 1024;
constexpr size_t WS_WIN = 14 * MiB;
constexpr size_t WS_WOUT = 19 * MiB;
constexpr size_t WS_WUP = 21 * MiB;
constexpr size_t WS_WGU = 22 * MiB;
constexpr size_t WS_WD = 110 * MiB;
constexpr size_t WS_X = 154 * MiB;
constexpr size_t WS_R1 = 282 * MiB;
constexpr size_t WS_R2 = 458 * MiB;
constexpr size_t WS_O = WS_R2 + 80 * MiB;
constexpr size_t WS_AP = 602 * MiB;
constexpr size_t AP_PO_BYTES = (size_t)3 * M * 6 * 64 * 2, AP_ML_BYTES = (size_t)3 * M * 6 * 4;
constexpr size_t WS_END = 682 * MiB;
static_assert(WS_AP + AP_PO_BYTES + 2 * AP_ML_BYTES <= WS_END, "ws map");

__device__ __forceinline__ unsigned f2bf(float f) { unsigned u = __builtin_bit_cast(unsigned, f); return (u + 0x7fffu + ((u >> 16) & 1u)) >> 16; }
__device__ __forceinline__ float bf2f(unsigned h) { return __builtin_bit_cast(float, h << 16); }
__device__ __forceinline__ unsigned pk2(float lo, float hi) { return f2bf(lo) | (f2bf(hi) << 16); }
__device__ __forceinline__ float wave_sum(float v) {
#pragma unroll
    for (int o = 1; o < 64; o <<= 1) v += __shfl_xor(v, o);
    return v;
}
__host__ __device__ __forceinline__ int perm16(int p) { return 4 * (p >> 3) + (p & 3) + 8 * ((p >> 2) & 1); }
__host__ __device__ __forceinline__ int perm32c(int p) { return 4 * (p >> 3) + (p & 3) + 16 * ((p >> 2) & 1); }
__host__ __device__ __forceinline__ int inproj_src(int n) {
    if (n >= NIN) return -1;
    if (n < COL_AV) { const int p = n & 63; return p < 16 ? (n - p) + perm16(p) : n; }
    if (n >= COL_CKR) return COL_CKR + perm32c(n - COL_CKR);
    return n;
}

#define GAS __attribute__((address_space(1)))
#define LAS __attribute__((address_space(3)))
enum { WM_IN = 0, WM_OUT = 1, WM_UP = 2, WM_GU = 3, WM_DN = 4 };
__device__ __forceinline__ void store8(bf16* p, const float* v) { u32x4 w; w.x = pk2(v[0], v[1]); w.y = pk2(v[2], v[3]); w.z = pk2(v[4], v[5]); w.w = pk2(v[6], v[7]); *(u32x4*)p = w; }
__device__ __forceinline__ void ld8(const bf16* p, float* v) { const u32x4 w = *(const u32x4*)p; v[0] = bf2f(w.x & 0xffffu); v[1] = bf2f(w.x >> 16); v[2] = bf2f(w.y & 0xffffu); v[3] = bf2f(w.y >> 16);
    v[4] = bf2f(w.z & 0xffffu); v[5] = bf2f(w.z >> 16); v[6] = bf2f(w.w & 0xffffu); v[7] = bf2f(w.w >> 16); }
namespace pg8 {
#define PG8_LAS __attribute__((address_space(3)))
typedef unsigned short bf16_t;
typedef short bf16x8 __attribute__((ext_vector_type(8)));
constexpr int BM = 256, BK = 64, HALF = 128, HTB = HALF * BK * 2  , STAGE_BYTES = 8 * HTB;
__host__ __device__ __forceinline__ int lds_byte(int r, int c) { const int st = (r >> 4) * 2 + (c >> 5), rr = r & 15, cc = c & 31, ob = rr * 64 + cc * 2; return st * 1024 + (ob ^ (((ob >> 9) & 1) << 5)); }
__host__ __device__ __forceinline__ void stage_rc(int b, int& R, int& C) { const int st = b / 1024, sb = b % 1024, swz = sb ^ (((sb >> 9) & 1) << 5); R = (st >> 1) * 16 + swz / 64; C = (st & 1) * 32 + (swz % 64) / 2; }
__host__ __device__ __forceinline__ int perm32(int rho) { const int n = rho >> 4, i = rho & 15; return 8 * (i >> 2) + 4 * n + (i & 3); }
struct Unit { int pm, pn; };
struct Gemm { const bf16_t* A; const bf16_t* Bt; int lda, ldb, K; };
template <bool GATHER_> struct PanelOrder {
    static constexpr bool GATHER = GATHER_;
    int pm, pn0, cnt; size_t a_tile, b_tile, b_base; const PG8_LAS int* rows;
    __device__ __forceinline__ bool next(int i, Unit& u) const { if (i >= cnt) return false; u.pm = pm; u.pn = pn0 + i; return true; }
    __device__ __forceinline__ size_t a_off(const Unit& u) const { return GATHER_ ? (size_t)0 : (size_t)u.pm * a_tile; }
    __device__ __forceinline__ size_t b_off(const Unit& u) const { return b_base + (size_t)u.pn * b_tile; }
    __device__ __forceinline__ const PG8_LAS int* rows_of(const Unit&) const { return rows; }
};
template <bool GATHER_> struct PairOrder {
    static constexpr bool GATHER = GATHER_;
    int pm0, h, nt, c0; size_t a_tile, b_tile, b_base; const PG8_LAS int* rows;
    __device__ __forceinline__ bool next(int i, Unit& u) const { if (i >= nt) return false; const int n0 = h ? nt - c0 : c0;
        if (i < n0) { u.pm = pm0; u.pn = (h ? c0 : 0) + i; } else { u.pm = pm0 + 1; u.pn = (h ? nt - c0 : 0) + (i - n0); } return true; }
    __device__ __forceinline__ size_t a_off(const Unit& u) const { return GATHER_ ? (size_t)0 : (size_t)u.pm * a_tile; }
    __device__ __forceinline__ size_t b_off(const Unit& u) const { return b_base + (size_t)u.pn * b_tile; }
    __device__ __forceinline__ const PG8_LAS int* rows_of(const Unit& u) const { return rows + 256 * (u.pm & 1); }
};
__device__ __forceinline__ unsigned cvt_pk_bf16(float lo, float hi) { unsigned r; asm volatile("v_cvt_pk_bf16_f32 %0, %1, %2" : "=v"(r) : "v"(lo), "v"(hi)); return r; }
__device__ __forceinline__ void rope4(f32x4& v0, f32x4& v1, const float* cs, const float* sn) {
    const f32x4 c = *(const f32x4*)cs, s = *(const f32x4*)sn; const f32x4 a = v0 * c - v1 * s, b = v1 * c + v0 * s; v0 = a; v1 = b; }
struct EpiIn {
    static constexpr bool PERM = true, AFTER_DRAIN = false, INIT_LOAD = false;
    bf16_t* P; const float* tab; const float* RSA;
    __device__ __forceinline__ void operator()(const f32x4 (&acc)[2][2][4][2], const Unit& u, int wr, int wc, int fr_, int fq_) const {
        int fr = fr_, fq = fq_; asm volatile("" : "+v"(fr), "+v"(fq));
        const int row0 = u.pm * BM + wr * 64 + fr;
        float rsa[2][4];
#pragma unroll
        for (int ai = 0; ai < 2; ++ai)
#pragma unroll
            for (int m = 0; m < 4; ++m) rsa[ai][m] = RSA[row0 + ai * HALF + m * 16];
#pragma unroll
        for (int bj = 0; bj < 2; ++bj) {
            const int gcol = u.pn * BM + bj * HALF + wc * 32;
            int cso = -1, sno = 0; float sc = 1.f; bool grope = false;
            if (gcol < COL_AV) { grope = (gcol & 63) == 0; if (grope && fq < 2) { cso = 4 * fq; sno = 8 + 4 * fq; } if (gcol < COL_AK) sc = QS_A; }
            else if (gcol >= COL_BQ && gcol < COL_BV) { grope = true; if (fq == 0) { cso = 16; sno = 20; } if (gcol < COL_BK) sc = QS_B; }
            else if (gcol == COL_CKR) { grope = true; cso = 24 + 4 * fq; sno = 40 + 4 * fq; }
            const int co = cso >= 0 ? cso : 0;
#pragma unroll
            for (int ai = 0; ai < 2; ++ai) {
                f32x4 cs[4], sn[4];
                if (grope) {
#pragma unroll
                    for (int m = 0; m < 4; ++m) { const float* tb = tab + (size_t)(row0 + ai * HALF + m * 16) * TABW; cs[m] = *(const f32x4*)(tb + co); sn[m] = *(const f32x4*)(tb + sno); } }
#pragma unroll
                for (int m = 0; m < 4; ++m) { const int t = row0 + ai * HALF + m * 16; f32x4 v0 = acc[ai][bj][m][0], v1 = acc[ai][bj][m][1];
                    if (grope && cso >= 0) { const f32x4 a = v0 * cs[m] - v1 * sn[m], b = v1 * cs[m] + v0 * sn[m]; v0 = a; v1 = b; }
                    const float scr = sc * rsa[ai][m]; v0 = v0 * scr; v1 = v1 * scr;
                    u32x4 w; w.x = cvt_pk_bf16(v0[0], v0[1]); w.y = cvt_pk_bf16(v0[2], v0[3]); w.z = cvt_pk_bf16(v1[0], v1[1]); w.w = cvt_pk_bf16(v1[2], v1[3]);
                    *(u32x4*)(P + (size_t)t * NINP + gcol + 8 * fq) = w; }
                asm volatile("" ::: "memory"); }
        }
    }
};
struct EpiUp {
    static constexpr bool PERM = true, AFTER_DRAIN = false, INIT_LOAD = false;
    bf16_t* U; const float* tab; const PG8_LAS float* rs;
    __device__ __forceinline__ void operator()(const f32x4 (&acc)[2][2][4][2], const Unit& u, int wr, int wc, int fr_, int fq_) const {
        int fr = fr_, fq = fq_; asm volatile("" : "+v"(fr), "+v"(fq));
        const int lr0 = wr * 64 + fr;
#pragma unroll
        for (int bj = 0; bj < 2; ++bj) {
            const int gcol = u.pn * BM + bj * HALF + wc * 32; const bool isq = gcol < UCOL_KV; const bool rope = gcol < 480 && ((gcol >> 5) % 3) == 2;
#pragma unroll
            for (int ai = 0; ai < 2; ++ai) {
                f32x4 cs[4], sn[4];
                if (rope) {
#pragma unroll
                    for (int m = 0; m < 4; ++m) { const float* tb = tab + (size_t)(u.pm * BM + lr0 + ai * HALF + m * 16) * TABW; cs[m] = *(const f32x4*)(tb + 24 + 4 * fq); sn[m] = *(const f32x4*)(tb + 40 + 4 * fq); } }
#pragma unroll
                for (int m = 0; m < 4; ++m) { const int lr = lr0 + ai * HALF + m * 16, t = u.pm * BM + lr; f32x4 v0 = acc[ai][bj][m][0], v1 = acc[ai][bj][m][1];
                    const float sc = rs[2 * lr + (isq ? 0 : 1)];
                    if (rope) { const f32x4 a = v0 * cs[m] - v1 * sn[m], b = v1 * cs[m] + v0 * sn[m]; v0 = a; v1 = b; }
                    v0 = v0 * sc; v1 = v1 * sc;
                    u32x4 w; w.x = cvt_pk_bf16(v0[0], v0[1]); w.y = cvt_pk_bf16(v0[2], v0[3]); w.z = cvt_pk_bf16(v1[0], v1[1]); w.w = cvt_pk_bf16(v1[2], v1[3]);
                    *(u32x4*)(U + (size_t)t * NUP + gcol + 8 * fq) = w; }
                asm volatile("" ::: "memory"); }
        }
    }
};
struct EpiOut {
    static constexpr bool PERM = true, AFTER_DRAIN = false, INIT_LOAD = true;
    bf16_t* XB; const float* XI;
    __device__ __forceinline__ void load_init(f32x4 (&acc)[2][2][4][2], const Unit& u, int wr, int wc, int fr_, int fq_) const {
        int fr = fr_, fq = fq_; asm volatile("" : "+v"(fr), "+v"(fq));
        const int row0 = u.pm * BM + wr * 64 + fr, col0 = u.pn * BM + wc * 32 + 8 * fq;
#pragma unroll
        for (int ai = 0; ai < 2; ++ai)
#pragma unroll
            for (int m = 0; m < 4; ++m) { const size_t off = (size_t)(row0 + ai * HALF + m * 16) * D + col0;
#pragma unroll
                for (int bj = 0; bj < 2; ++bj) {
                    if (XI) { acc[ai][bj][m][0] = *(const f32x4*)(XI + off + bj * HALF); acc[ai][bj][m][1] = *(const f32x4*)(XI + off + bj * HALF + 4); }
                    else { const u32x4 w = *(const u32x4*)(XB + off + bj * HALF);
                        acc[ai][bj][m][0] = (f32x4){bf2f(w.x & 0xffffu), bf2f(w.x >> 16), bf2f(w.y & 0xffffu), bf2f(w.y >> 16)}; acc[ai][bj][m][1] = (f32x4){bf2f(w.z & 0xffffu), bf2f(w.z >> 16), bf2f(w.w & 0xffffu), bf2f(w.w >> 16)}; } } }
    }
    __device__ __forceinline__ void operator()(const f32x4 (&acc)[2][2][4][2], const Unit& u, int wr, int wc, int fr_, int fq_) const {
        int fr = fr_, fq = fq_; asm volatile("" : "+v"(fr), "+v"(fq));
        const int row0 = u.pm * BM + wr * 64 + fr, col0 = u.pn * BM + wc * 32 + 8 * fq;
#pragma unroll
        for (int ai = 0; ai < 2; ++ai)
#pragma unroll
            for (int m = 0; m < 4; ++m) { bf16_t* rowp = XB + (size_t)(row0 + ai * HALF + m * 16) * D + col0;
#pragma unroll
                for (int bj = 0; bj < 2; ++bj) { const f32x4 v0 = acc[ai][bj][m][0], v1 = acc[ai][bj][m][1];
                    u32x4 w; w.x = cvt_pk_bf16(v0[0], v0[1]); w.y = cvt_pk_bf16(v0[2], v0[3]); w.z = cvt_pk_bf16(v1[0], v1[1]); w.w = cvt_pk_bf16(v1[2], v1[3]);
                    *(u32x4*)(rowp + bj * HALF) = w; } }
    }
};
struct EpiG1 {
    static constexpr bool PERM = true, AFTER_DRAIN = false, INIT_LOAD = false;
    bf16_t* ACT; const float* RSTD; const PG8_LAS int* rows;
    __device__ __forceinline__ void operator()(const f32x4 (&acc)[2][2][4][2], const Unit& u, int wr, int wc, int fr_, int fq_) const {
        int fr = fr_, fq = fq_; asm volatile("" : "+v"(fr), "+v"(fq));
        const int row0 = u.pm * BM + wr * 64 + fr, col0 = u.pn * HALF + wc * 32 + 8 * fq;
        float rsdv[2][4];
#pragma unroll
        for (int ai = 0; ai < 2; ++ai)
#pragma unroll
            for (int m = 0; m < 4; ++m) rsdv[ai][m] = RSTD[rows[(u.pm & 1) * BM + ai * HALF + wr * 64 + m * 16 + fr]];
#pragma unroll
        for (int ai = 0; ai < 2; ++ai)
#pragma unroll
            for (int m = 0; m < 4; ++m) { float a[8]; const float rsd = rsdv[ai][m];
#pragma unroll
                for (int n = 0; n < 2; ++n)
#pragma unroll
                    for (int j = 0; j < 4; ++j) { const float g = acc[ai][0][m][n][j] * rsd, up = acc[ai][1][m][n][j] * rsd;
                        a[4 * n + j] = g * __builtin_amdgcn_rcpf(1.0f + __builtin_amdgcn_exp2f(-g * LOG2E)) * up; }
                u32x4 w; w.x = cvt_pk_bf16(a[0], a[1]); w.y = cvt_pk_bf16(a[2], a[3]); w.z = cvt_pk_bf16(a[4], a[5]); w.w = cvt_pk_bf16(a[6], a[7]);
                *(u32x4*)(ACT + (size_t)(row0 + ai * HALF + m * 16) * FF + col0) = w; }
    }
};
struct EpiBf16 {
    static constexpr bool PERM = true, AFTER_DRAIN = false, INIT_LOAD = false;
    bf16_t* O; int ldc;
    __device__ __forceinline__ void operator()(const f32x4 (&acc)[2][2][4][2], const Unit& u, int wr, int wc, int fr_, int fq_) const {
        int fr = fr_, fq = fq_; asm volatile("" : "+v"(fr), "+v"(fq));
        const int row0 = u.pm * BM + wr * 64 + fr, col0 = u.pn * BM + wc * 32 + 8 * fq;
#pragma unroll
        for (int ai = 0; ai < 2; ++ai)
#pragma unroll
            for (int m = 0; m < 4; ++m) { bf16_t* rowp = O + (size_t)(row0 + ai * HALF + m * 16) * ldc + col0;
#pragma unroll
                for (int bj = 0; bj < 2; ++bj) { const f32x4 v0 = acc[ai][bj][m][0], v1 = acc[ai][bj][m][1];
                    u32x4 w; w.x = cvt_pk_bf16(v0[0], v0[1]); w.y = cvt_pk_bf16(v0[2], v0[3]); w.z = cvt_pk_bf16(v1[0], v1[1]); w.w = cvt_pk_bf16(v1[2], v1[3]);
                    *(u32x4*)(rowp + bj * HALF) = w; } }
    }
};

template <class Epi, class Sched, bool ALIGN_EPI>
__device__ __forceinline__ void gemm_phase(PG8_LAS unsigned char* lds, const Gemm g, const Sched& S, const Epi& E, int tid_in) {
    int tid_ = tid_in; asm volatile("" : "+v"(tid_));
    const int tid = tid_, wid = __builtin_amdgcn_readfirstlane(tid >> 6), lane = tid & 63, wr = wid >> 2, wc = wid & 3, fr = lane & 15, fq = lane >> 4;
    const int K = g.K, nt = K / BK;
    unsigned voffA0[2], voffA1[2], voffB[2];
    Unit cur, nxt; int ui = 0;
    if (!S.next(0, cur)) return;
#pragma unroll
    for (int i = 0; i < 2; ++i) { int R, C; stage_rc(tid * 16 + i * 8192, R, C); const int Rb = Epi::PERM ? ((R & ~31) + perm32(R & 31)) : R;
        if constexpr (Sched::GATHER) { const PG8_LAS int* rw = S.rows_of(cur); voffA0[i] = (unsigned)rw[R] * (unsigned)(g.lda * 2) + (unsigned)C * 2u; voffA1[i] = (unsigned)rw[R + HALF] * (unsigned)(g.lda * 2) + (unsigned)C * 2u; }
        else { voffA0[i] = (unsigned)(R * g.lda + C) * 2u; voffA1[i] = 0u; }
        voffB[i] = (unsigned)(Rb * g.ldb + C) * 2u; }
    const size_t kstep = (size_t)(BK * 2);
    const size_t hstepB = (size_t)HALF * g.ldb * 2;
    const size_t hstepA = Sched::GATHER ? (size_t)0 : (size_t)HALF * g.lda * 2;
#define PG8_STAGE_A1(bufoff, gbase) do { if constexpr (Sched::GATHER) PG8_STAGE(bufoff, gbase, voffA1); else PG8_STAGE(bufoff, (gbase) + hstepA, voffA0); } while (0)
    const unsigned ldsw = (unsigned)wid * 1024u;
    const int aoff = lds_byte(wr * 64 + fr, fq * 8), boff = lds_byte(wc * 32 + fr, fq * 8);
#define PG8_SA(b, h) (((b) * 2 + (h)) * HTB)
#define PG8_SB(b, h) ((4 + (b) * 2 + (h)) * HTB)
#define PG8_STAGE(bufoff, gbase, voff) do { _Pragma("unroll") for (int _i = 0; _i < 2; ++_i) \
        __builtin_amdgcn_global_load_lds((const unsigned*)((const char*)(gbase) + (voff)[_i]), (PG8_LAS unsigned*)(lds + (bufoff) + ldsw + _i * 8192), 16, 0, 0); } while (0)
#define PG8_LDA(dst, b, h) do { _Pragma("unroll") for (int m = 0; m < 4; ++m) _Pragma("unroll") for (int k = 0; k < 2; ++k) dst[m][k] = *(const PG8_LAS bf16x8*)(lds + PG8_SA(b, h) + aoff + m * 2048 + k * 1024); } while (0)
#define PG8_LDB(dst, b, h) do { _Pragma("unroll") for (int n = 0; n < 2; ++n) _Pragma("unroll") for (int k = 0; k < 2; ++k) dst[n][k] = *(const PG8_LAS bf16x8*)(lds + PG8_SB(b, h) + boff + n * 2048 + k * 1024); } while (0)
#define PG8_MMA(ai, bj, At, Bt) do { __builtin_amdgcn_s_setprio(1); _Pragma("unroll") for (int m = 0; m < 4; ++m) _Pragma("unroll") for (int n = 0; n < 2; ++n) _Pragma("unroll") for (int k = 0; k < 2; ++k) \
        acc[ai][bj][m][n] = __builtin_amdgcn_mfma_f32_16x16x32_bf16(Bt[n][k], At[m][k], acc[ai][bj][m][n], 0, 0, 0); __builtin_amdgcn_s_setprio(0); } while (0)
#define PG8_WAIT_V(n) asm volatile("s_waitcnt vmcnt(" #n ")" ::: "memory")
#define PG8_WAIT_L(n) asm volatile("s_waitcnt lgkmcnt(" #n ")" ::: "memory")
#define PG8_BAR __builtin_amdgcn_s_barrier()
#define PG8_SCHED __builtin_amdgcn_sched_barrier(0)
    f32x4 acc[2][2][4][2];
    if constexpr (Epi::INIT_LOAD) E.load_init(acc, cur, wr, wc, fr, fq);
    else {
#pragma unroll
    for (int a = 0; a < 2; ++a)
#pragma unroll
        for (int b = 0; b < 2; ++b)
#pragma unroll
            for (int m = 0; m < 4; ++m)
#pragma unroll
                for (int n = 0; n < 2; ++n) acc[a][b][m][n] = (f32x4){0.f, 0.f, 0.f, 0.f};
    }
    bf16x8 At[4][2], B0[2][2], B1[2][2];
    const char* cA = (const char*)g.A + S.a_off(cur); const char* cB = (const char*)g.Bt + S.b_off(cur);
    PG8_STAGE(PG8_SB(0, 0), cB, voffB); PG8_STAGE(PG8_SB(0, 1), cB + hstepB, voffB); PG8_STAGE(PG8_SA(0, 0), cA, voffA0); PG8_STAGE_A1(PG8_SA(0, 1), cA);
    if (wr == 1) PG8_BAR;
    PG8_WAIT_V(2); PG8_BAR;
    PG8_STAGE(PG8_SB(1, 0), cB + kstep, voffB); PG8_STAGE(PG8_SA(1, 0), cA + kstep, voffA0); PG8_STAGE(PG8_SB(1, 1), cB + hstepB + kstep, voffB);
    PG8_WAIT_V(6); PG8_BAR;
    for (;;) {
        const bool has_next = S.next(ui + 1, nxt);
        const char* nA = has_next ? (const char*)g.A + S.a_off(nxt) : cA; const char* nB = has_next ? (const char*)g.Bt + S.b_off(nxt) : cB;
#pragma unroll 1
        for (int t = 0; t < nt; t += 2) {
            const bool last = (t == nt - 2);
            const char* a1 = cA + (size_t)(t + 1) * kstep;
            const char* a2 = last ? nA : cA + (size_t)(t + 2) * kstep; const char* b2 = last ? nB : cB + (size_t)(t + 2) * kstep;
            const char* a3 = a2 + kstep; const char* b3 = b2 + kstep;
            PG8_LDB(B0, 0, 0); PG8_LDB(B1, 0, 1); PG8_SCHED; PG8_LDA(At, 0, 0); PG8_STAGE_A1(PG8_SA(1, 1), a1);
            if constexpr (Sched::GATHER) { if (last && has_next && nxt.pm != cur.pm) {
                const PG8_LAS int* rw = S.rows_of(nxt); const int tid2 = wid * 64 + (int)__builtin_amdgcn_mbcnt_hi(~0u, __builtin_amdgcn_mbcnt_lo(~0u, 0u));
#pragma unroll
                for (int i = 0; i < 2; ++i) { int R, C; stage_rc(tid2 * 16 + i * 8192, R, C); voffA0[i] = (unsigned)rw[R] * (unsigned)(g.lda * 2) + (unsigned)C * 2u; voffA1[i] = (unsigned)rw[R + HALF] * (unsigned)(g.lda * 2) + (unsigned)C * 2u; } } }
            PG8_WAIT_V(8); PG8_WAIT_L(0); PG8_BAR; PG8_MMA(0, 0, At, B0); PG8_MMA(0, 1, At, B1); PG8_BAR; PG8_SCHED;
            PG8_LDA(At, 0, 1); PG8_STAGE(PG8_SB(0, 0), b2, voffB); PG8_STAGE(PG8_SB(0, 1), b2 + hstepB, voffB); PG8_STAGE(PG8_SA(0, 0), a2, voffA0);
            PG8_WAIT_V(8); PG8_WAIT_L(0); PG8_BAR; PG8_MMA(1, 0, At, B0); PG8_MMA(1, 1, At, B1); PG8_BAR; PG8_SCHED;
            PG8_LDB(B0, 1, 0); PG8_LDB(B1, 1, 1); PG8_SCHED; PG8_LDA(At, 1, 0); PG8_STAGE_A1(PG8_SA(0, 1), a2);
            PG8_WAIT_V(8); PG8_WAIT_L(0); PG8_BAR; PG8_MMA(0, 0, At, B0); PG8_MMA(0, 1, At, B1); PG8_BAR; PG8_SCHED;
            PG8_LDA(At, 1, 1); PG8_STAGE(PG8_SB(1, 0), b3, voffB); PG8_STAGE(PG8_SB(1, 1), b3 + hstepB, voffB); PG8_STAGE(PG8_SA(1, 0), a3, voffA0);
            PG8_WAIT_V(8); PG8_WAIT_L(0); PG8_BAR; PG8_MMA(1, 0, At, B0); PG8_MMA(1, 1, At, B1); PG8_BAR; PG8_SCHED;
        }
        if constexpr (ALIGN_EPI) { if (wr == 0) PG8_BAR; }
        E(acc, cur, wr, wc, fr, fq);
        if (!has_next) break;
        if constexpr (Epi::INIT_LOAD) E.load_init(acc, nxt, wr, wc, fr, fq);
        else {
#pragma unroll
        for (int a = 0; a < 2; ++a)
#pragma unroll
            for (int b = 0; b < 2; ++b)
#pragma unroll
                for (int m = 0; m < 4; ++m)
#pragma unroll
                    for (int n = 0; n < 2; ++n) acc[a][b][m][n] = (f32x4){0.f, 0.f, 0.f, 0.f};
        }
        cur = nxt; cA = nA; cB = nB; ++ui;
        if constexpr (ALIGN_EPI) { if (wr == 1) PG8_BAR; }
    }
    PG8_WAIT_V(0);
    if constexpr (!ALIGN_EPI) { if (wr == 0) PG8_BAR; }
    PG8_BAR;
#undef PG8_SA
#undef PG8_SB
#undef PG8_STAGE
#undef PG8_STAGE_A1
#undef PG8_LDA
#undef PG8_LDB
#undef PG8_MMA
#undef PG8_WAIT_V
#undef PG8_WAIT_L
#undef PG8_BAR
#undef PG8_SCHED
}
}

#define XB_TMO      128
#define XB_XCNT(j)  (256  + 64 * (j))
#define XB_XSUB(j)  (1280 + 64 * (j))
#define XB_XGEN(j)  (2304 + 64 * (j))
#define XB_TOP      3328
#define XB_TOPGEN   3392
#define XCD_BAR_WORDS 3456
#define XB_SPIN_CAP (1u << 24)

__device__ __forceinline__ unsigned xb_ld(unsigned* p)              { return __hip_atomic_load(p, __ATOMIC_RELAXED, __HIP_MEMORY_SCOPE_AGENT); }
__device__ __forceinline__ unsigned xb_add(unsigned* p, unsigned v) { return __hip_atomic_fetch_add(p, v, __ATOMIC_RELAXED, __HIP_MEMORY_SCOPE_AGENT); }
__device__ __forceinline__ unsigned xb_xcc_id() { return (unsigned)__builtin_amdgcn_s_getreg((3 << 11) | 20) & 0xFu; }
#define XB_SPIN(cond, bar) do { unsigned _sp = 0; while (cond) { __builtin_amdgcn_s_sleep(1); \
    if ((++_sp & 255u) == 0u) { if (xb_ld(&(bar)[XB_TMO])) break; if (_sp > XB_SPIN_CAP) { atomicAdd(&(bar)[XB_TMO], 1u); break; } } } } while (0)

struct XcdBarrier {
    unsigned* bar; unsigned x;
    volatile LAS unsigned* st;
};

__device__ __forceinline__ XcdBarrier xcd_barrier_post(unsigned* bar, volatile LAS unsigned* st) {
    XcdBarrier b; b.bar = bar; b.x = xb_xcc_id(); b.st = st;
    if (threadIdx.x == 0) (void)xb_add(&bar[XB_XCNT(b.x)], 1u);
    return b;
}
__device__ __forceinline__ void xcd_barrier_complete(unsigned* bar, unsigned x, unsigned& nloc, unsigned& nx) {
    const unsigned G = gridDim.x * gridDim.y * gridDim.z;
    unsigned sum, cnt, mine, sp = 0u;
    for (;;) {
        sum = 0u; cnt = 0u; mine = 0u;
#pragma unroll
        for (unsigned j = 0; j < 16; ++j) { const unsigned c = xb_ld(&bar[XB_XCNT(j)]); sum += c; cnt += (c > 0u) ? 1u : 0u; mine = (j == x) ? c : mine; }
        if (sum == G) break;
        __builtin_amdgcn_s_sleep(1);
        if ((++sp & 255u) == 0u) { if (xb_ld(&bar[XB_TMO])) break; if (sp > XB_SPIN_CAP) { atomicAdd(&bar[XB_TMO], 1u); break; } }
    }
    nloc = mine > 0u ? mine : 1u; nx = cnt > 0u ? cnt : 1u;
}

__device__ __forceinline__ void xcd_barrier(const XcdBarrier& b, int tid) {
    asm volatile("s_waitcnt vmcnt(0)" ::: "memory");
    __syncthreads();
    if (tid == 0) {
        unsigned* bar = b.bar;
        __builtin_amdgcn_s_waitcnt(0);
        unsigned nloc = b.st[0], nx = b.st[1];
        if (nloc == 0u) { xcd_barrier_complete(bar, b.x, nloc, nx); b.st[0] = nloc; b.st[1] = nx; }
        const unsigned old = xb_add(&bar[XB_XSUB(b.x)], 1u);
        const unsigned gen = old / nloc;
        if (old + 1u == (gen + 1u) * nloc) {
            __builtin_amdgcn_fence(__ATOMIC_RELEASE, "agent");
            asm volatile("s_waitcnt vmcnt(0)" ::: "memory");
            const unsigned og = xb_add(&bar[XB_TOP], 1u);
            const unsigned tg = og / nx;
            if (og + 1u == (tg + 1u) * nx) xb_add(&bar[XB_TOPGEN], 1u);
            else XB_SPIN(xb_ld(&bar[XB_TOPGEN]) == tg, bar);
            __builtin_amdgcn_fence(__ATOMIC_ACQUIRE, "agent");
            xb_add(&bar[XB_XGEN(b.x)], 1u);
            asm volatile("s_waitcnt vmcnt(0)" ::: "memory");
        } else {
            XB_SPIN(xb_ld(&bar[XB_XGEN(b.x)]) == gen, bar);
            __builtin_amdgcn_fence(__ATOMIC_ACQUIRE, "agent");
            asm volatile("s_waitcnt vmcnt(0)" ::: "memory");
        }
    }
    __syncthreads();
}

constexpr int NWAVES = 8, NTHR = NWAVES * 64, GRID = 256;
constexpr int RING_BYTES = 131072;
constexpr int LDS_ROWS = RING_BYTES;
constexpr int LDS_RS = LDS_ROWS + 2048;
constexpr int LDS_MISC = LDS_RS + 2048;
constexpr int LDS_AP2 = LDS_MISC + 512;
constexpr int LDS_BYTES = 155648;
static_assert(LDS_AP2 + 8 * 2048 + 8 * 256 <= LDS_BYTES, "LDS map");
constexpr int CW_BAR = 4096;
constexpr int CW_PAIR = 16384;
constexpr int NPHASE = 8 * DEPTH + 1;
#ifndef ACOMB_DED
#define ACOMB_DED 30
#endif
constexpr int NWC = 2;

struct Args { const float* in[22]; float* out; unsigned char* ws; int ph_lo, ph_hi, sub, pad; };
typedef const __attribute__((address_space(4))) Args CArgs;
struct Frame {
    LAS unsigned char* lds; int tid, lane, wave, vcu, gw;
    CArgs* a;
};
#define LDS_WAIT() asm volatile("s_waitcnt lgkmcnt(0)" ::: "memory")

struct WDesc { int mode; const float* src; const float* src2; const float* g; const float* g2; const float* g3; float gscale; bf16* dst; int K; };
__device__ __forceinline__ float wgain(const WDesc& w, int k) {
    switch (w.mode) {
    case WM_IN: case WM_GU: return w.g[k];
    case WM_OUT: return k < 384 ? w.g[k] : (k < 704 ? w.g2[(k - 384) & 63] * w.gscale : w.g3[k - 704]);
    case WM_UP: return k < 192 ? w.g[k] : (k < 320 ? w.g2[k - 192] : 0.f);
    default: return 1.f; }
}
__device__ __forceinline__ void wconv_tile(const WDesc& w, int n0, int k0, LAS unsigned* scr, int lane) {
    LAS float* gs = (LAS float*)(scr + 32 * 65);
    const int n = n0 + lane; const float* colp = nullptr; int ld = 1, klo = 0, khi = 0;
    switch (w.mode) {
    case WM_IN: { const int c = inproj_src(n); if (c >= 0) { colp = w.src + c; } ld = NIN; khi = D; } break;
    case WM_OUT: colp = w.src + n; ld = D; khi = D; break;
    case WM_UP: if (n < 480) { const int h = n / 96, p = n % 96; colp = w.src + h * 96 + (p < 64 ? p : 64 + perm32c(p - 64)); ld = 480; khi = 192; }
                else if (n >= UCOL_KV && n < UCOL_KV + 640) { colp = w.src2 + (n - UCOL_KV); ld = 640; klo = 192; khi = 320; } break;
    case WM_GU: { const int t = n >> 8, r = n & 255; colp = (r < 128 ? w.src : w.src2) + 128 * t + (r & 127); ld = FF; khi = D; } break;
    default: colp = w.src + n; ld = D; khi = FF; break; }
    const bool ok = colp != nullptr && k0 >= klo && k0 < khi;
    const float* p = ok ? colp + (size_t)(k0 - klo) * ld : w.src; if (!ok) ld = 1;
    gs[lane] = wgain(w, k0 + lane);
    LDS_WAIT(); asm volatile("" ::: "memory");
    const float msk = ok ? 1.f : 0.f;
    { float v[64];
#pragma unroll
      for (int i = 0; i < 64; ++i) v[i] = __builtin_nontemporal_load(p + (size_t)i * ld);
#pragma unroll
      for (int i = 0; i < 64; i += 2) scr[(i >> 1) * 65 + lane] = pk2(v[i] * gs[i] * msk, v[i + 1] * gs[i + 1] * msk); }
    LDS_WAIT(); asm volatile("" ::: "memory");
    const int c = lane & 7;
#pragma unroll
    for (int j = 0; j < 8; ++j) { const int nn = (lane >> 3) + 8 * j; u32x4 o; o.x = scr[(4 * c + 0) * 65 + nn]; o.y = scr[(4 * c + 1) * 65 + nn]; o.z = scr[(4 * c + 2) * 65 + nn]; o.w = scr[(4 * c + 3) * 65 + nn];
        __builtin_nontemporal_store(o, (u32x4*)(w.dst + (size_t)(n0 + nn) * w.K + k0 + 8 * c)); }
    LDS_WAIT(); asm volatile("" ::: "memory");
}
__device__ __forceinline__ void ph_wconv(Frame& F, int l, int part, int wi, int nw) {
    CArgs& A = *F.a; unsigned char* ws = A.ws;
    LAS unsigned* scr = (LAS unsigned*)(F.lds + F.wave * 16384);
    const float lam_init = 0.8f - 0.6f * expf(-0.3f * (float)l);
    constexpr int I_IN = 40 * 16, I_OUT = 16 * 16, I_UP = 20 * 6, I_GU1 = 44 * 16, I_DN1 = 16 * 22, NIT = I_IN + I_OUT + I_UP + NE * (I_GU1 + I_DN1);
    const int it_end = part == 0 ? I_IN + I_OUT + I_UP : NIT;
#pragma unroll 1
    for (int it = (part == 0 ? 0 : I_IN + I_OUT + I_UP) + wi; it < it_end; it += nw) {
        int r = it; WDesc w; w.src2 = nullptr; w.g = nullptr; w.g2 = nullptr; w.g3 = nullptr; w.gscale = 1.f; int nt;
        if (r < I_IN) { w.mode = WM_IN; w.src = A.in[3] + (size_t)l * D * NIN; w.g = A.in[2] + l * D; w.dst = (bf16*)(ws + WS_WIN); w.K = D; nt = 40; }
        else if ((r -= I_IN) < I_OUT) { w.mode = WM_OUT; w.src = A.in[15] + (size_t)l * D * D; w.g = A.in[13] + l * 384; w.g2 = A.in[8] + l * 64; w.g3 = A.in[14] + l * 320; w.gscale = 1.0f - lam_init; w.dst = (bf16*)(ws + WS_WOUT); w.K = D; nt = 16; }
        else if ((r -= I_OUT) < I_UP) { w.mode = WM_UP; w.src = A.in[10] + (size_t)l * 192 * 480; w.src2 = A.in[12] + (size_t)l * 128 * 640; w.g = A.in[9] + l * 192; w.g2 = A.in[11] + l * 128; w.dst = (bf16*)(ws + WS_WUP); w.K = KUP; nt = 20; }
        else { r -= I_UP; const int e = r / (I_GU1 + I_DN1); r -= e * (I_GU1 + I_DN1);
            if (r < I_GU1) { w.mode = WM_GU; w.src = A.in[18] + ((size_t)l * NE + e) * D * FF; w.src2 = A.in[19] + ((size_t)l * NE + e) * D * FF; w.g = A.in[16] + l * D; w.dst = (bf16*)(ws + WS_WGU) + (size_t)e * NGU * D; w.K = D; nt = 44; }
            else { r -= I_GU1; w.mode = WM_DN; w.src = A.in[20] + ((size_t)l * NE + e) * FF * D; w.dst = (bf16*)(ws + WS_WD) + (size_t)e * D * FF; w.K = FF; nt = 16; } }
        wconv_tile(w, (r % nt) * 64, (r / nt) * 64, scr, F.lane);
    }
}
__device__ __forceinline__ void ph_tab(Frame& F) {
    const int* pos = (const int*)F.a->in[1]; float* tab = (float*)(F.a->ws + WS_TAB);
    for (int i = blockIdx.x * NTHR + F.tid; i < M * 28; i += GRID * NTHR) {
        const int t = i / 28, f = i % 28; const float p = (float)pos[t]; float inv; int co, so;
        if (f < 8) { inv = 1.0f / powf(500000.0f, (float)(2 * f) / 16.0f); co = f; so = 8 + f; }
        else if (f < 12) { const int j = f - 8; inv = 1.0f / powf(500000.0f, (float)(2 * j) / 8.0f); co = 16 + j; so = 20 + j; }
        else { const int j = f - 12; inv = 1.0f / powf(10000.0f, (float)(2 * j) / 32.0f); co = 24 + j; so = 40 + j; }
        float s, c; sincosf(p * inv, &s, &c); tab[(size_t)t * TABW + co] = c; tab[(size_t)t * TABW + so] = s; }
}
struct RowGather { u32x4 y[4][2]; float g[4]; int n; };
__device__ __forceinline__ void rg_issue(RowGather& R, unsigned& mask, int selv, int b, const bf16* Y, const float* GATE, int lane) {
    R.n = 0;
#pragma unroll
    for (int k = 0; k < 4; ++k) {
        if (mask != 0u) { const int e = __builtin_ctz(mask); mask &= mask - 1u; const int j = __builtin_amdgcn_readlane(selv, e); const int r = (e * NB + b) * CAP + j;
            R.g[k] = GATE[r]; const u32x4* y = (const u32x4*)(Y + (size_t)r * D) + lane;
#pragma unroll
            for (int q = 0; q < 2; ++q) R.y[k][q] = y[64 * q];
            R.n = k + 1; }
        else { R.g[k] = 0.f;
#pragma unroll
            for (int q = 0; q < 2; ++q) R.y[k][q] = (u32x4){0u, 0u, 0u, 0u}; } }
}
__device__ __forceinline__ void bf8_to_f32(const u32x4 w, f32x4& a, f32x4& b) { a = (f32x4){bf2f(w.x & 0xffffu), bf2f(w.x >> 16), bf2f(w.y & 0xffffu), bf2f(w.y >> 16)}; b = (f32x4){bf2f(w.z & 0xffffu), bf2f(w.z >> 16), bf2f(w.w & 0xffffu), bf2f(w.w >> 16)}; }
__device__ __forceinline__ void rg_add(const RowGather& R, f32x4 (&v)[4]) {
#pragma unroll
    for (int k = 0; k < 4; ++k) { const float g = R.g[k];
#pragma unroll
        for (int q = 0; q < 2; ++q) { f32x4 a, b; bf8_to_f32(R.y[k][q], a, b); v[2 * q] += a * g; v[2 * q + 1] += b * g; } }
}
__device__ __forceinline__ void ph_entry(Frame& F, int mode) {
    CArgs& A = *F.a; unsigned char* ws = A.ws; const float* xin = A.in[0]; bf16* XB = (bf16*)(A.ws + WS_X); float* RSTDA = (float*)(ws + WS_RSTDA);
    const bf16* Y = (const bf16*)(ws + WS_R2); const int* SEL = (const int*)(ws + WS_SEL); const float* GATE = (const float*)(ws + WS_GATE);
    constexpr int STR = GRID * NWAVES;
#pragma unroll 1
    for (int t0 = F.gw; t0 < M; t0 += 2 * STR) {
        const int tt[2] = {t0, t0 + STR};
        f32x4 v[2][4]; int selv[2]; unsigned mask[2] = {0u, 0u}; RowGather R[2];
#pragma unroll
        for (int h = 0; h < 2; ++h) {
            if (mode == 0) { const f32x4* src = (const f32x4*)(xin + (size_t)tt[h] * D) + 2 * F.lane;
#pragma unroll
                for (int j = 0; j < 2; ++j) { v[h][2 * j] = src[128 * j]; v[h][2 * j + 1] = src[128 * j + 1]; } }
            else { selv[h] = SEL[(size_t)tt[h] * NE + (F.lane & 15)]; const u32x4* src = (const u32x4*)(XB + (size_t)tt[h] * D) + F.lane;
#pragma unroll
                for (int j = 0; j < 2; ++j) bf8_to_f32(src[64 * j], v[h][2 * j], v[h][2 * j + 1]); } }
        if (mode != 0) {
#pragma unroll
            for (int h = 0; h < 2; ++h) mask[h] = (unsigned)(__ballot(selv[h] >= 0) & 0xffffull);
#pragma unroll
            for (int h = 0; h < 2; ++h) rg_issue(R[h], mask[h], selv[h], tt[h] / S, Y, GATE, F.lane);
#pragma unroll
            for (int h = 0; h < 2; ++h) rg_add(R[h], v[h]);
            while ((mask[0] | mask[1]) != 0u) {
#pragma unroll
                for (int h = 0; h < 2; ++h) rg_issue(R[h], mask[h], selv[h], tt[h] / S, Y, GATE, F.lane);
#pragma unroll
                for (int h = 0; h < 2; ++h) rg_add(R[h], v[h]); }
        }
#pragma unroll
        for (int h = 0; h < 2; ++h) { const int t = tt[h]; float s = 0.f;
#pragma unroll
            for (int j = 0; j < 4; ++j) s += (v[h][j].x * v[h][j].x + v[h][j].y * v[h][j].y) + (v[h][j].z * v[h][j].z + v[h][j].w * v[h][j].w);
            const float rstd = 1.0f / sqrtf(wave_sum(s) * (1.0f / D) + 1e-6f);
            if (mode == 2) { f32x4* o = (f32x4*)(A.out + (size_t)t * D) + 2 * F.lane; const f32x4* g = (const f32x4*)A.in[21] + 2 * F.lane;
#pragma unroll
                for (int j = 0; j < 2; ++j) { o[128 * j] = v[h][2 * j] * rstd * g[128 * j]; o[128 * j + 1] = v[h][2 * j + 1] * rstd * g[128 * j + 1]; } }
            else { u32x4* o16 = (u32x4*)(XB + (size_t)t * D) + F.lane; if (F.lane == 0) RSTDA[t] = rstd;
#pragma unroll
                for (int j = 0; j < 2; ++j) { u32x4 w; w.x = pk2(v[h][2 * j].x, v[h][2 * j].y); w.y = pk2(v[h][2 * j].z, v[h][2 * j].w); w.z = pk2(v[h][2 * j + 1].x, v[h][2 * j + 1].y); w.w = pk2(v[h][2 * j + 1].z, v[h][2 * j + 1].w); o16[64 * j] = w; } } }
    }
}
__device__ __forceinline__ void ph_router(Frame& F, int l) {
    CArgs& A = *F.a; unsigned char* wsb = A.ws; const bf16* Xp = (const bf16*)(A.ws + WS_X); float* AFF = (float*)(wsb + WS_AFF); float* RSTD = (float*)(wsb + WS_RSTD);
    const float* g = A.in[16] + l * D; const float* wr = A.in[17] + (size_t)l * D * NE;
    LAS float* GW = (LAS float*)F.lds;
    LAS float* XT = (LAS float*)(F.lds + 65536) + F.wave * (16 * 132);
    for (int i = F.tid; i < D * NE / 4; i += NTHR) { const f32x4 w4 = ((const f32x4*)wr)[i]; const float gg = g[i >> 2]; *(LAS f32x4*)(GW + 4 * i) = w4 * gg; }
    __syncthreads();
    const int t0 = F.gw * 16, r = F.lane & 15, q = F.lane >> 4;
    const u32x2* src = (const u32x2*)(Xp + (size_t)(t0 + (F.lane >> 5)) * D) + (F.lane & 31);
    f32x4 acc = (f32x4){0.f, 0.f, 0.f, 0.f}; float ssq = 0.f;
    u32x2 v[8];
#pragma unroll
    for (int i = 0; i < 8; ++i) v[i] = src[(size_t)i * 2 * (D / 4)];
#pragma unroll 1
    for (int c = 0; c < 8; ++c) {
#pragma unroll
        for (int i = 0; i < 8; ++i) *(LAS f32x4*)(XT + (2 * i + (F.lane >> 5)) * 132 + 4 * (F.lane & 31)) = (f32x4){bf2f(v[i].x & 0xffffu), bf2f(v[i].x >> 16), bf2f(v[i].y & 0xffffu), bf2f(v[i].y >> 16)};
        if (c < 7) {
#pragma unroll
            for (int i = 0; i < 8; ++i) v[i] = src[(size_t)i * 2 * (D / 4) + (c + 1) * 32]; }
        LDS_WAIT(); asm volatile("" ::: "memory");
        const LAS float* ap = XT + r * 132 + q; const LAS float* bp = GW + (size_t)(c * 128 + q) * 16 + r;
#pragma unroll
        for (int jj = 0; jj < 32; ++jj) { const float a = ap[4 * jj], b = bp[64 * jj]; ssq += a * a; acc = __builtin_amdgcn_mfma_f32_16x16x4f32(a, b, acc, 0, 0, 0); }
        LDS_WAIT(); asm volatile("" ::: "memory");
    }
    ssq += __shfl_xor(ssq, 16); ssq += __shfl_xor(ssq, 32);
    const float rstd = 1.0f / sqrtf(ssq * (1.0f / D) + 1e-6f);
    if (q == 0) RSTD[t0 + r] = rstd;
    f32x4 aff;
#pragma unroll
    for (int k = 0; k < 4; ++k) { const float rs = __shfl(rstd, 4 * q + k); float lg = acc[k] * rs; float mx = lg;
        mx = fmaxf(mx, __shfl_xor(mx, 1)); mx = fmaxf(mx, __shfl_xor(mx, 2)); mx = fmaxf(mx, __shfl_xor(mx, 4)); mx = fmaxf(mx, __shfl_xor(mx, 8));
        const float ex = expf(lg - mx); float den = ex; den += __shfl_xor(den, 1); den += __shfl_xor(den, 2); den += __shfl_xor(den, 4); den += __shfl_xor(den, 8);
        aff[k] = ex / den; }
    const int b = t0 / S, s0 = t0 % S;
    *(f32x4*)(AFF + ((size_t)b * NE + r) * S + s0 + 4 * q) = aff;
}
__device__ __forceinline__ void topk_select(Frame& F, int b, int e, int half, LAS int* rows) {
    unsigned char* ws = F.a->ws; const float* AFF = (const float*)(ws + WS_AFF); float* GATE = (float*)(ws + WS_GATE); int* SEL = (int*)(ws + WS_SEL); int* IDX = (int*)(ws + WS_IDX);
    LAS unsigned* hist = (LAS unsigned*)F.lds; LAS unsigned* wsum = hist + 256; LAS unsigned* bc = hist + 272;
    unsigned k[8]; { const u32x4* src = (const u32x4*)(AFF + ((size_t)b * NE + e) * S) + 2 * F.tid; const u32x4 a = src[0], c = src[1]; k[0] = a.x; k[1] = a.y; k[2] = a.z; k[3] = a.w; k[4] = c.x; k[5] = c.y; k[6] = c.z; k[7] = c.w; }
    unsigned prefix = 0u, need = CAP;
    for (int pass = 0; pass < 4; ++pass) { const int shift = 24 - 8 * pass;
        if (F.tid < 256) hist[F.tid] = 0u;
        __syncthreads();
#pragma unroll
        for (int i = 0; i < 8; ++i) if (pass == 0 || (k[i] >> (shift + 8)) == prefix) atomicAdd((unsigned*)&hist[(k[i] >> shift) & 255u], 1u);
        __syncthreads();
        if (F.wave == 0) { const unsigned c0 = hist[4 * F.lane], c1 = hist[4 * F.lane + 1], c2 = hist[4 * F.lane + 2], c3 = hist[4 * F.lane + 3]; const unsigned s = c0 + c1 + c2 + c3; unsigned suf = s;
#pragma unroll
            for (int o = 1; o < 64; o <<= 1) { const unsigned t = __shfl_down(suf, o); if (F.lane + o < 64) suf += t; }
            const unsigned above = suf - s;
            if (above < need && need <= suf) { unsigned run = above; int d;
                if (run + c3 >= need) d = 3; else { run += c3; if (run + c2 >= need) d = 2; else { run += c2; if (run + c1 >= need) d = 1; else { run += c1; d = 0; } } }
                bc[0] = (prefix << 8) | (unsigned)(4 * F.lane + d); bc[1] = need - run; } }
        __syncthreads();
        prefix = bc[0]; need = bc[1];
        __syncthreads();
    }
    const unsigned T = prefix;
    unsigned cg = 0u, ce = 0u;
#pragma unroll
    for (int i = 0; i < 8; ++i) { cg += k[i] > T ? 1u : 0u; ce += k[i] == T ? 1u : 0u; }
    unsigned pk = cg | (ce << 16), inc = pk;
#pragma unroll
    for (int o = 1; o < 64; o <<= 1) { const unsigned t = __shfl_up(inc, o); if (F.lane >= o) inc += t; }
    if (F.lane == 63) wsum[F.wave] = inc;
    __syncthreads();
    unsigned base = 0u;
#pragma unroll
    for (int w = 0; w < NWAVES; ++w) base += (w < F.wave) ? wsum[w] : 0u;
    unsigned run = base + inc - pk; unsigned G = run & 0xffffu, E = run >> 16;
#pragma unroll
    for (int i = 0; i < 8; ++i) { const bool gt = k[i] > T, eq = k[i] == T; const bool sel = gt || (eq && E < need); const unsigned slot = G + (E < need ? E : need);
        const int tok = b * S + 8 * F.tid + i;
        if (sel) { rows[slot] = tok; if ((int)(slot >> 8) == half) { const int r = (e * NB + b) * CAP + (int)slot; GATE[r] = __builtin_bit_cast(float, k[i]); IDX[r] = tok; } }
        if (half == 0) SEL[(size_t)tok * NE + e] = sel ? (int)slot : -1;
        G += gt ? 1u : 0u; E += eq ? 1u : 0u; }
    __syncthreads();
}
#ifndef PROBE_DUP
#define PROBE_DUP -1
#endif
#ifndef PROBE_SUB
#define PROBE_SUB 7
#endif
#ifndef PROBE_REPS
#define PROBE_REPS 1
#endif
namespace fa {
typedef float f32x16 __attribute__((ext_vector_type(16)));
typedef short s16x4 __attribute__((ext_vector_type(4)));
typedef short v4i16_t __attribute__((ext_vector_type(4)));
using pg8::bf16x8;
typedef LAS const char* lds_cptr;
constexpr int KOFF = 0, KSLOT_MAX = 12288, VOFF = 4 * KSLOT_MAX, VSLOT = 8192, WSOFF = VOFF + 4 * VSLOT, OSTOFF = WSOFF + 8 * 256, FA_LDS = OSTOFF + 8 * 4096;
static_assert(FA_LDS <= RING_BYTES, "attention LDS");
__device__ __forceinline__ int crow(int r, int hi) { return (r & 3) + 8 * (r >> 2) + 4 * hi; }
typedef float f32x2_t __attribute__((ext_vector_type(2))); typedef __bf16 bf16x2_t __attribute__((ext_vector_type(2)));
__device__ __forceinline__ unsigned cvtpk(float lo, float hi) { const f32x2_t v = {lo, hi}; const bf16x2_t b = __builtin_convertvector(v, bf16x2_t); return __builtin_bit_cast(unsigned, b); }
__device__ __forceinline__ s16x4 vtr(lds_cptr p) { return __builtin_bit_cast(s16x4, __builtin_amdgcn_ds_read_tr16_b64_v4i16((LAS v4i16_t*)p)); }
__device__ __forceinline__ float swap_max(float m) { auto rr = __builtin_amdgcn_permlane32_swap(__float_as_uint(m), __float_as_uint(m), false, false); return __builtin_fmaxf(__uint_as_float(rr[0]), __uint_as_float(rr[1])); }
__device__ __forceinline__ float swap_add(float m) { auto rr = __builtin_amdgcn_permlane32_swap(__float_as_uint(m), __float_as_uint(m), false, false); return __uint_as_float(rr[0]) + __uint_as_float(rr[1]); }
__device__ __forceinline__ void glds16(const void* base, unsigned voff, unsigned lds_dst) { unsigned keep;
    asm volatile("s_mov_b32 %0, m0\n\ts_mov_b32 m0, %3\n\ts_nop 0\n\tglobal_load_lds_dwordx4 %1, %2\n\ts_mov_b32 m0, %0" : "=&s"(keep) : "v"(voff), "s"(base), "s"(lds_dst) : "memory"); }
__device__ __forceinline__ unsigned lds_addr(LAS unsigned char* p) { return (unsigned)__builtin_amdgcn_readfirstlane((int)(unsigned)(size_t)p); }
#define FA_WAITV(N) asm volatile("s_waitcnt vmcnt(%0)" ::"n"(N) : "memory")
#define FA_BAR() asm volatile("s_waitcnt lgkmcnt(0)\n\ts_barrier" ::: "memory")
struct Src { const bf16* q; int ldq; const bf16* k0; int ldk0; const bf16* k1; int ldk1; const bf16* v; int ldv; bf16* o; };
template <int KS> __device__ __forceinline__ void qk_tile(f32x16& p0, f32x16& p1, lds_cptr kp, const bf16x8* qf, const f32x16& init) {
#pragma unroll
    for (int k = 0; k < KS; ++k) { const bf16x8 k0 = *(const LAS bf16x8*)(kp + k * 2048), k1 = *(const LAS bf16x8*)(kp + k * 2048 + 512);
        p0 = __builtin_amdgcn_mfma_f32_32x32x16_bf16(k0, qf[k], k == 0 ? init : p0, 0, 0, 0);
        p1 = __builtin_amdgcn_mfma_f32_32x32x16_bf16(k1, qf[k], k == 0 ? init : p1, 0, 0, 0); }
}
template <bool NEGM> __device__ __forceinline__ void sm_max(f32x16& p0, f32x16& p1, float& mhat, float& lsum, f32x16& o0, f32x16& o1, f32x16& negm, LAS float* wsf, bool first, bool live, int r32, int hi) {
    float ma = __builtin_fmaxf(p0[0], p1[0]), mb = __builtin_fmaxf(p0[1], p1[1]);
#pragma unroll
    for (int r = 2; r < 16; r += 2) { ma = __builtin_fmaxf(ma, __builtin_fmaxf(p0[r], p1[r])); mb = __builtin_fmaxf(mb, __builtin_fmaxf(p0[r + 1], p1[r + 1])); }
    const float rm = swap_max(__builtin_fmaxf(ma, mb));
    if (live && (first || __any(rm > 8.0f))) {
        const float dl = first ? rm : __builtin_fmaxf(rm, 0.f); mhat += dl;
#pragma unroll
        for (int r = 0; r < 16; ++r) { p0[r] -= dl; p1[r] -= dl; if constexpr (NEGM) negm[r] = -mhat; }
        if (!first) { const float f = __builtin_amdgcn_exp2f(-dl); lsum *= f; if (hi == 0) wsf[r32] = f;
#pragma unroll
            for (int r = 0; r < 16; ++r) { const float fr = wsf[crow(r, hi)]; o0[r] *= fr; o1[r] *= fr; } }
    }
}
template <int KS, bool SPLIT>
__device__ __forceinline__ void unit1(const Src& s, int q0, float lam, float eps, LAS unsigned char* lds, int tid) {
    constexpr int NPC = SPLIT ? 8 : 2 * KS, KSLOT = NPC * 1024, OPS = NPC > 8 ? 3 : 2, NT = S / 64, NKF = KS < 3 ? 2 * KS : 6;
    constexpr int NSL = SPLIT ? 8 : 6, LEAD = NSL - 3, KOFF = 0, VOFF = NSL * KSLOT, WSOFF = VOFF + NSL * VSLOT, OSTOFF = VOFF;
    static_assert(WSOFF + 2048 <= LDS_MISC && (!SPLIT || NSL * VSLOT >= 32768), "unit1 LDS");
    const int lane = tid & 63, r32 = lane & 31, hi = lane >> 5, wid = __builtin_amdgcn_readfirstlane(tid >> 6);
    const int grp = SPLIT ? (wid >> 2) : 0, qw = SPLIT ? (wid & 3) : wid;
    const unsigned koffA = (unsigned)(lane * s.ldk0 + wid * 8) * 2u, koffB = (unsigned)(lane * s.ldk1 + (wid & 3) * 8) * 2u;
    const unsigned voff = (unsigned)((16 * (wid & 3) + (lane >> 2)) * s.ldv + (wid >> 2) * 32 + (lane & 3) * 8) * 2u;
#define FA_DMA(t, slot) do { \
        glds16((const char*)s.k0 + (size_t)(t) * 128 * s.ldk0, koffA, lds_addr(lds + KOFF + (slot) * KSLOT + wid * 1024)); \
        if constexpr (NPC > 8) glds16((const char*)s.k1 + (size_t)(t) * 128 * s.ldk1, koffB, lds_addr(lds + KOFF + (slot) * KSLOT + (8 + (wid & 3)) * 1024)); \
        glds16((const char*)s.v + (size_t)(t) * 128 * s.ldv, voff, lds_addr(lds + VOFF + (slot) * VSLOT + wid * 1024)); } while (0)
    LAS float* wsf = (LAS float*)(lds + WSOFF) + wid * 64;
    FA_WAITV(0); FA_BAR();
    _Pragma("unroll") for (int i_ = 0; i_ < NSL - 1; ++i_) FA_DMA(i_, i_);
    bf16x8 qf[KS];
    { const bf16* qrow = s.q + (size_t)(q0 + qw * 32 + r32) * s.ldq + grp * (KS * 16) + hi * 8;
#pragma unroll
      for (int k = 0; k < KS; ++k) qf[k] = *(const bf16x8*)(qrow + 16 * k); }
    float mhat = 0.f, lsum = 0.f; f32x16 o0 = f32x16{}, o1 = f32x16{}, ol = f32x16{}, negm = f32x16{};
    const int kro = hi * 1024 + r32 * 16 + grp * (KS * 2048);
    const int vro = ((lane >> 4) & 1) * 32 + (lane & 3) * 8 + (4 * hi + ((lane & 15) >> 2)) * 64;
    const bf16x8 ones = (bf16x8){0x3F80, 0x3F80, 0x3F80, 0x3F80, 0x3F80, 0x3F80, 0x3F80, 0x3F80};
    f32x16 pA0, pA1, pB0, pB1;
    FA_WAITV((NSL - 3) * OPS); FA_BAR();
    qk_tile<KS>(pA0, pA1, (lds_cptr)(lds + KOFF + kro), qf, negm);
    sm_max<true>(pA0, pA1, mhat, lsum, o0, o1, negm, wsf, true, true, r32, hi);
    bf16x8 kf[NKF];
    { const lds_cptr kpn = (lds_cptr)(lds + KOFF + 1 * KSLOT + kro);
#pragma unroll
      for (int i = 0; i < NKF; ++i) kf[i] = *(const LAS bf16x8*)(kpn + (i >> 1) * 2048 + (i & 1) * 512); }
    int slot = 0;
#define SB() __builtin_amdgcn_sched_barrier(0)
#define EX(x) __builtin_amdgcn_exp2f(x)
#define EXx(P0_, P1_, i) do { f32x16& P_ = (i) < 8 ? P0_ : P1_; constexpr int b_ = (2 * (i)) & 15; P_[b_] = EX(P_[b_]); P_[b_ + 1] = EX(P_[b_ + 1]); } while (0)
#define CVx(P0_, P1_, i) do { f32x16& P_ = (i) < 8 ? P0_ : P1_; constexpr int b_ = (2 * (i)) & 15; pw[(i) >> 2][(i) & 3] = cvtpk(P_[b_], P_[b_ + 1]); } while (0)
#define MX3(d, a, b, c) asm("v_max3_f32 %0, %1, %2, %3" : "=v"(d) : "v"(a), "v"(b), "v"(c))
#define MXp(N0_, N1_, j) do { MX3(ma, ma, N0_[4 * (j)], N1_[4 * (j)]); MX3(mb, mb, N0_[4 * (j) + 1], N1_[4 * (j) + 1]); MX3(ma, ma, N0_[4 * (j) + 2], N1_[4 * (j) + 2]); MX3(mb, mb, N0_[4 * (j) + 3], N1_[4 * (j) + 3]); } while (0)
#define KLD(i, k, h) kf[i] = *(const LAS bf16x8*)(kpn + (k) * 2048 + (h) * 512)
#define KL2(i, k, h) kf[i] = *(const LAS bf16x8*)(kp2 + (k) * 2048 + (h) * 512)
#define VF(i) ((bf16x8){vlo[i][0], vlo[i][1], vlo[i][2], vlo[i][3], vhi[i][0], vhi[i][1], vhi[i][2], vhi[i][3]})
#define PW(k) __builtin_bit_cast(bf16x8, pw[k])
#define MF(A, B, C) __builtin_amdgcn_mfma_f32_32x32x16_bf16(A, B, C, 0, 0, 0)
#define FA_STEP(C0, C1, N0, N1) do { \
        FA_WAITV((NSL - 4) * OPS); FA_BAR(); \
        { const int tn = t + NSL - 1 < NT ? t + NSL - 1 : NT - 1; FA_DMA(tn, slot >= 1 ? slot - 1 : NSL - 1); } \
        const int sn = slot + 1 < NSL ? slot + 1 : 0, sn2 = sn + 1 < NSL ? sn + 1 : 0; const bool live = t + 1 < NT; \
        const lds_cptr kpn = (lds_cptr)(lds + KOFF + sn * KSLOT + kro), kp2 = (lds_cptr)(lds + KOFF + sn2 * KSLOT + kro); const lds_cptr vp = (lds_cptr)(lds + VOFF + slot * VSLOT + vro); \
        s16x4 vlo[8], vhi[8]; u32x4 pw[4]; float ma = -INFINITY, mb = -INFINITY; \
        _Pragma("unroll") for (int i = 0; i < 8; ++i) { vlo[i] = vtr(vp + (i >> 2) * 4096 + (i & 3) * 1024); vhi[i] = vtr(vp + (i >> 2) * 4096 + (i & 3) * 1024 + 512); } \
        SB(); __builtin_amdgcn_s_setprio(1); \
        if constexpr (KS == 2) { \
            EXx(C0, C1, 0); EXx(C0, C1, 1); EXx(C0, C1, 2); CVx(C0, C1, 0); CVx(C0, C1, 1); SB(); \
            N0 = MF(kf[0], qf[0], negm); EXx(C0, C1, 3); CVx(C0, C1, 2); SB(); \
            N1 = MF(kf[1], qf[0], negm); EXx(C0, C1, 4); CVx(C0, C1, 3); SB(); \
            N0 = MF(kf[2], qf[1], N0); EXx(C0, C1, 5); CVx(C0, C1, 4); SB(); \
            N1 = MF(kf[3], qf[1], N1); EXx(C0, C1, 6); CVx(C0, C1, 5); SB(); \
            o0 = MF(PW(0), VF(0), o0); EXx(C0, C1, 7); CVx(C0, C1, 6); SB(); \
            o1 = MF(PW(0), VF(4), o1); EXx(C0, C1, 8); CVx(C0, C1, 7); SB(); \
            ol = MF(PW(0), ones, ol); KL2(0, 0, 0); KL2(1, 0, 1); EXx(C0, C1, 9); CVx(C0, C1, 8); SB(); \
            o0 = MF(PW(1), VF(1), o0); KL2(2, 1, 0); KL2(3, 1, 1); EXx(C0, C1, 10); CVx(C0, C1, 9); SB(); \
            o1 = MF(PW(1), VF(5), o1); EXx(C0, C1, 11); CVx(C0, C1, 10); SB(); \
            ol = MF(PW(1), ones, ol); EXx(C0, C1, 12); CVx(C0, C1, 11); SB(); \
            o0 = MF(PW(2), VF(2), o0); EXx(C0, C1, 13); CVx(C0, C1, 12); SB(); \
            o1 = MF(PW(2), VF(6), o1); EXx(C0, C1, 14); CVx(C0, C1, 13); SB(); \
            ol = MF(PW(2), ones, ol); EXx(C0, C1, 15); CVx(C0, C1, 14); CVx(C0, C1, 15); SB(); \
            o0 = MF(PW(3), VF(3), o0); MXp(N0, N1, 0); SB(); \
            o1 = MF(PW(3), VF(7), o1); MXp(N0, N1, 1); SB(); \
            ol = MF(PW(3), ones, ol); MXp(N0, N1, 2); MXp(N0, N1, 3); SB(); \
        } else { \
            EXx(C0, C1, 0); EXx(C0, C1, 1); CVx(C0, C1, 0); SB(); \
            N0 = MF(kf[0], qf[0], negm); EXx(C0, C1, 2); CVx(C0, C1, 1); SB(); \
            N1 = MF(kf[1], qf[0], negm); KLD(0, 3, 0); KLD(1, 3, 1); EXx(C0, C1, 3); CVx(C0, C1, 2); SB(); \
            N0 = MF(kf[2], qf[1], N0); EXx(C0, C1, 4); CVx(C0, C1, 3); SB(); \
            N1 = MF(kf[3], qf[1], N1); KLD(2, 4, 0); KLD(3, 4, 1); EXx(C0, C1, 5); CVx(C0, C1, 4); SB(); \
            N0 = MF(kf[4], qf[2], N0); EXx(C0, C1, 6); CVx(C0, C1, 5); SB(); \
            N1 = MF(kf[5], qf[2], N1); KLD(4, 5, 0); KLD(5, 5, 1); EXx(C0, C1, 7); CVx(C0, C1, 6); SB(); \
            N0 = MF(kf[0], qf[3], N0); EXx(C0, C1, 8); CVx(C0, C1, 7); SB(); \
            N1 = MF(kf[1], qf[3], N1); EXx(C0, C1, 9); CVx(C0, C1, 8); SB(); \
            N0 = MF(kf[2], qf[4], N0); EXx(C0, C1, 10); CVx(C0, C1, 9); SB(); \
            N1 = MF(kf[3], qf[4], N1); EXx(C0, C1, 11); CVx(C0, C1, 10); SB(); \
            N0 = MF(kf[4], qf[5], N0); EXx(C0, C1, 12); CVx(C0, C1, 11); SB(); \
            N1 = MF(kf[5], qf[5], N1); EXx(C0, C1, 13); CVx(C0, C1, 12); SB(); \
            o0 = MF(PW(0), VF(0), o0); EXx(C0, C1, 14); CVx(C0, C1, 13); SB(); \
            o1 = MF(PW(0), VF(4), o1); EXx(C0, C1, 15); CVx(C0, C1, 14); SB(); \
            ol = MF(PW(0), ones, ol); CVx(C0, C1, 15); SB(); \
            o0 = MF(PW(1), VF(1), o0); KL2(0, 0, 0); KL2(1, 0, 1);  SB(); \
            o1 = MF(PW(1), VF(5), o1); KL2(2, 1, 0); KL2(3, 1, 1);  SB(); \
            ol = MF(PW(1), ones, ol); KL2(4, 2, 0); KL2(5, 2, 1);  SB(); \
            o0 = MF(PW(2), VF(2), o0); MXp(N0, N1, 0); SB(); \
            o1 = MF(PW(2), VF(6), o1); MXp(N0, N1, 1); SB(); \
            ol = MF(PW(2), ones, ol); MXp(N0, N1, 2); SB(); \
            o0 = MF(PW(3), VF(3), o0); MXp(N0, N1, 3); SB(); \
            o1 = MF(PW(3), VF(7), o1);  SB(); \
            ol = MF(PW(3), ones, ol);  SB(); \
        } \
        __builtin_amdgcn_s_setprio(0); \
          \
        { const float rm = swap_max(__builtin_fmaxf(ma, mb)); \
          if (live && __any(rm > 8.0f)) { \
              const float dl = __builtin_fmaxf(rm, 0.f); mhat += dl; \
              _Pragma("unroll") for (int r = 0; r < 16; ++r) { N0[r] -= dl; N1[r] -= dl; negm[r] = -mhat; } \
              const float f = __builtin_amdgcn_exp2f(-dl); if (hi == 0) wsf[r32] = f; \
              _Pragma("unroll") for (int r = 0; r < 16; ++r) { const float fr = wsf[crow(r, hi)]; o0[r] *= fr; o1[r] *= fr; ol[r] *= fr; } } } \
        slot = sn; } while (0)
    static_assert(KS == 2 || KS == 6, "unit1: schedules exist for KS = 2 and KS = 6");
#pragma unroll 1
    for (int t = 0; t < NT; t += 2) {
        FA_STEP(pA0, pA1, pB0, pB1);
        ++t; FA_STEP(pB0, pB1, pA0, pA1); --t;
    }
#undef FA_STEP
#undef SB
#undef EX
#undef EXx
#undef CVx
#undef MXp
#undef MX3
#undef KLD
#undef KL2
#undef VF
#undef PW
#undef MF
    f32x16 out[2];
#pragma unroll
    for (int r = 0; r < 16; ++r) { const float il = 1.0f / ol[r]; out[0][r] = o0[r] * il; out[1][r] = o1[r] * il; }
    FA_WAITV(0); FA_BAR();
    if constexpr (SPLIT) {
        LAS float* xch = (LAS float*)(lds + OSTOFF) + (size_t)qw * 2048;
        if (grp == 1) {
#pragma unroll
            for (int r = 0; r < 16; ++r) { xch[r * 64 + lane] = lam * out[0][r]; xch[(16 + r) * 64 + lane] = lam * out[1][r]; } }
        FA_BAR();
        if (grp == 1) return;
#pragma unroll
        for (int r = 0; r < 16; ++r) { out[0][r] -= xch[r * 64 + lane]; out[1][r] -= xch[(16 + r) * 64 + lane]; }
    }
    bf16* Ow = s.o + (size_t)(q0 + qw * 32) * D;
    LAS bf16* stg = (LAS bf16*)(lds + KOFF) + qw * 2048;
#pragma unroll
    for (int r = 0; r < 16; ++r) { float ss = out[0][r] * out[0][r] + out[1][r] * out[1][r];
        ss += __shfl_xor(ss, 1); ss += __shfl_xor(ss, 2); ss += __shfl_xor(ss, 4); ss += __shfl_xor(ss, 8); ss += __shfl_xor(ss, 16);
        const float rstd = 1.0f / sqrtf(ss * (1.0f / 64.0f) + eps); const int orow = crow(r, hi);
        stg[orow * 64 + r32] = (bf16)f2bf(out[0][r] * rstd); stg[orow * 64 + 32 + r32] = (bf16)f2bf(out[1][r] * rstd); }
#pragma unroll
    for (int i = 0; i < 4; ++i) { const int row = i * 8 + (lane >> 3), ch = lane & 7; const u32x4 v = *(const LAS u32x4*)(stg + row * 64 + ch * 8); *(u32x4*)(Ow + (size_t)row * D + ch * 8) = v; }
#undef FA_DMA
}
}

__device__ __forceinline__ void ph_attn_bc(Frame& F, int l) {
    unsigned char* ws = F.a->ws; const bf16* P = (const bf16*)(ws + WS_R1); const bf16* U = (const bf16*)(ws + WS_R2); bf16* O = (bf16*)(ws + WS_O);
    const float *lq1 = F.a->in[4] + l * 32, *lk1 = F.a->in[5] + l * 32, *lq2 = F.a->in[6] + l * 32, *lk2 = F.a->in[7] + l * 32;
    float d1 = 0.f, d2 = 0.f; for (int j = 0; j < 32; ++j) { d1 += lq1[j] * lk1[j]; d2 += lq2[j] * lk2[j]; }
    const float lam = expf(d1) - expf(d2) + (0.8f - 0.6f * expf(-0.3f * (float)l));
    if (F.a->sub & 2) {
    { const int xg = F.vcu >> 5, w = F.vcu & 31; const int nb = w < 20 ? 5 : 6, k0 = w < 20 ? w : 100 + (w - 20), ks = w < 20 ? 20 : 10;
#pragma unroll 1
    for (int i = 0; i < nb; ++i) { const int k = k0 + ks * i, bh = xg + 8 * (k >> 5), qb = k & 31, b = bh / 5, h = bh % 5; const bf16* pb = P + (size_t)b * S * NINP;
        fa::Src sr{pb + COL_BQ + h * 64, NINP, pb + COL_BK + h * 64, NINP, pb + COL_BK + h * 64, NINP, pb + COL_BV + h * 64, NINP, O + (size_t)b * S * D + 384 + h * 64};
        fa::unit1<2, true>(sr, qb * 128, lam, 1e-5f, F.lds, F.tid); } }
    }
    asm volatile("s_waitcnt vmcnt(0) lgkmcnt(0)\n\ts_barrier" ::: "memory");
    if (F.a->sub & 4) { const int xg = F.vcu >> 5, w = F.vcu & 31; const int nc = w < 20 ? 3 : 2, k0 = w < 20 ? w : 60 + (w - 20), ks = w < 20 ? 20 : 10;
#pragma unroll 1
    for (int i = 0; i < nc; ++i) { const int k = k0 + ks * i, bh = xg + 8 * (k >> 4), qb = k & 15, b = bh / 5, h = bh % 5; const bf16* ub = U + (size_t)b * S * NUP;
        fa::Src sr{ub + h * 96, NUP, ub + UCOL_KV + h * 128, NUP, P + (size_t)b * S * NINP + COL_CKR, NINP, ub + UCOL_KV + h * 128 + 64, NUP, O + (size_t)b * S * D + 704 + h * 64};
        fa::unit1<6, false>(sr, qb * 256, 0.f, 1e-6f, F.lds, F.tid); } }
    asm volatile("s_waitcnt vmcnt(0) lgkmcnt(0)\n\ts_barrier" ::: "memory");
}
namespace fa {
constexpr int AK_CH = 384 * 16, AV_DH = 384 * 64, AKOFF = 0, AVOFF = 8 * AK_CH, AWSOFF = AVOFF + 2 * AV_DH, ASTOFF = AWSOFF + 2048;
static_assert(ASTOFF + 8 * 4096 <= LDS_MISC, "A-pattern LDS");
struct AUnit { const bf16* Pb; int h, sh, c, U0, L; size_t rowbase; };
__device__ __forceinline__ AUnit aunit_decode(const bf16* P, int u) { const int bh = u / 48, rem = u % 48, pat = rem >> 4, blk = rem & 15, b = bh / 6, bpc = 16 >> (2 * pat);
    AUnit a; a.Pb = P + (size_t)b * S * NINP; a.h = bh % 6; a.sh = 2 * pat; a.c = blk / bpc; a.U0 = (blk % bpc) * 256; a.L = S >> a.sh; a.rowbase = (size_t)pat * M + (size_t)b * S; return a; }
__device__ __forceinline__ void aunit_dma(const AUnit& a, LAS unsigned char* lds, int wid, int lane) {
#pragma unroll
    for (int j = 0; j < 6; ++j) { const int pid = wid + 8 * j, ch = pid / 6, rg = pid % 6; int u = a.U0 - 64 + 64 * rg + lane; u = u < 0 ? 0 : (u >= a.L ? a.L - 1 : u);
        glds16(a.Pb, (unsigned)((a.c + (u << a.sh)) * NINP + COL_AK + a.h * 64 + ch * 8) * 2u, lds_addr(lds + AKOFF + ch * AK_CH + rg * 1024)); }
#pragma unroll
    for (int j = 0; j < 6; ++j) { const int pid = wid + 8 * j, dh = pid / 24, rg = pid % 24; int u = a.U0 - 64 + 16 * rg + (lane >> 2); u = u < 0 ? 0 : (u >= a.L ? a.L - 1 : u);
        glds16(a.Pb, (unsigned)((a.c + (u << a.sh)) * NINP + COL_AV + a.h * 64 + dh * 32 + (lane & 3) * 8) * 2u, lds_addr(lds + AVOFF + dh * AV_DH + rg * 1024)); }
}
}
__device__ __forceinline__ void ph_apat(Frame& F) {
    using namespace fa;
    unsigned char* ws = F.a->ws; const bf16* P = (const bf16*)(ws + WS_R1); bf16* PO = (bf16*)(ws + WS_AP); float* PM = (float*)(ws + WS_AP + AP_PO_BYTES); float* PL = (float*)(ws + WS_AP + AP_PO_BYTES + AP_ML_BYTES);
    LAS unsigned char* lds = F.lds; const int tid = F.tid, lane = tid & 63, r32 = lane & 31, hi = lane >> 5, wid = __builtin_amdgcn_readfirstlane(tid >> 6);
    const int e = F.vcu >> 1, u0 = e * 18 + ((F.vcu & 1) ? 8 : 0), n = (F.vcu & 1) ? 10 : 8;
    LAS float* wsf = (LAS float*)(lds + AWSOFF) + wid * 64; LAS bf16* stg = (LAS bf16*)(lds + ASTOFF) + wid * 2048;
    const int vro = ((lane >> 4) & 1) * 32 + (lane & 3) * 8 + (4 * hi + ((lane & 15) >> 2)) * 64;
    const bf16x8 ones = (bf16x8){0x3F80, 0x3F80, 0x3F80, 0x3F80, 0x3F80, 0x3F80, 0x3F80, 0x3F80};
    FA_WAITV(0); FA_BAR();
    AUnit a = aunit_decode(P, u0); aunit_dma(a, lds, wid, lane);
    AUnit prev = a; int prev_uq = 0; float pm_keep = 0.f; f32x16 pl_keep = f32x16{};
#define APAT_FLUSH() do { \
        if (hi == 0) PM[(prev.rowbase + (size_t)(prev.c + (prev_uq << prev.sh))) * 6 + prev.h] = pm_keep; \
        if (r32 == 0) { _Pragma("unroll") for (int r = 0; r < 16; ++r) PL[(prev.rowbase + (size_t)(prev.c + ((prev.U0 + 32 * wid + crow(r, hi)) << prev.sh))) * 6 + prev.h] = pl_keep[r]; } \
        _Pragma("unroll") for (int q = 0; q < 4; ++q) { const int row = q * 8 + (lane >> 3), ch = lane & 7; const u32x4 v = *(const LAS u32x4*)(stg + row * 64 + ch * 8); \
            const size_t t = prev.rowbase + (size_t)(prev.c + ((prev.U0 + 32 * wid + row) << prev.sh)); *(u32x4*)(PO + (t * 6 + prev.h) * 64 + ch * 8) = v; } } while (0)
    bf16x8 qf[4];
    { const bf16* qrow = a.Pb + (size_t)(a.c + ((a.U0 + 32 * wid + r32) << a.sh)) * NINP + COL_AQ + a.h * 64 + hi * 8;
#pragma unroll
      for (int k = 0; k < 4; ++k) qf[k] = *(const bf16x8*)(qrow + 16 * k); }
#pragma unroll 1
    for (int i = 0; i < n; ++i) {
        FA_WAITV(0); FA_BAR();
        if (i > 0) APAT_FLUSH();
        const int uq = a.U0 + 32 * wid + r32, L = a.L;
        float m = -1e30f; f32x16 o0 = f32x16{}, o1 = f32x16{}, ol = f32x16{};
#pragma unroll
        for (int j = 0; j < 3; ++j) {
            const int st0 = wid + 2 * j, st1 = st0 + 1;
            const lds_cptr kp0 = (lds_cptr)(lds + AKOFF + hi * AK_CH + (32 * st0 + r32) * 16), kp1 = kp0 + 512;
            f32x16 p0 = f32x16{}, p1 = f32x16{};
#pragma unroll
            for (int k = 0; k < 4; ++k) { p0 = __builtin_amdgcn_mfma_f32_32x32x16_bf16(*(const LAS bf16x8*)(kp0 + 2 * k * AK_CH), qf[k], p0, 0, 0, 0);
                if (j < 2) p1 = __builtin_amdgcn_mfma_f32_32x32x16_bf16(*(const LAS bf16x8*)(kp1 + 2 * k * AK_CH), qf[k], p1, 0, 0, 0); }
            float rm = -INFINITY;
#pragma unroll
            for (int r = 0; r < 16; ++r) { const int d0 = 64 * j - 64 + crow(r, hi) - r32, k0 = uq + d0; const bool ok0 = d0 >= -64 && d0 <= 64 && k0 >= 0 && k0 < L; p0[r] = ok0 ? p0[r] : -INFINITY; rm = __builtin_fmaxf(rm, p0[r]);
                if (j < 2) { const int d1 = d0 + 32, k1 = uq + d1; const bool ok1 = d1 >= -64 && d1 <= 64 && k1 >= 0 && k1 < L; p1[r] = ok1 ? p1[r] : -INFINITY; rm = __builtin_fmaxf(rm, p1[r]); } }
            rm = swap_max(rm);
            if (__any(rm > m + 8.0f)) {
                const float mn = __builtin_fmaxf(m, rm), f = __builtin_amdgcn_exp2f(m - mn); m = mn; if (hi == 0) wsf[r32] = f;
#pragma unroll
                for (int r = 0; r < 16; ++r) { const float fr = wsf[crow(r, hi)]; o0[r] *= fr; o1[r] *= fr; ol[r] *= fr; } }
            u32x4 pw[4];
#pragma unroll
            for (int q = 0; q < 4; ++q) { pw[0][q] = cvtpk(__builtin_amdgcn_exp2f(p0[2 * q] - m), __builtin_amdgcn_exp2f(p0[2 * q + 1] - m)); pw[1][q] = cvtpk(__builtin_amdgcn_exp2f(p0[8 + 2 * q] - m), __builtin_amdgcn_exp2f(p0[9 + 2 * q] - m));
                if (j < 2) { pw[2][q] = cvtpk(__builtin_amdgcn_exp2f(p1[2 * q] - m), __builtin_amdgcn_exp2f(p1[2 * q + 1] - m)); pw[3][q] = cvtpk(__builtin_amdgcn_exp2f(p1[8 + 2 * q] - m), __builtin_amdgcn_exp2f(p1[9 + 2 * q] - m)); } }
            const lds_cptr vp = (lds_cptr)(lds + AVOFF + 32 * st0 * 64 + vro);
#pragma unroll
            for (int kk = 0; kk < (j < 2 ? 4 : 2); ++kk) { const bf16x8 pa = __builtin_bit_cast(bf16x8, pw[kk]);
                const s16x4 l0 = vtr(vp + kk * 1024), h0 = vtr(vp + kk * 1024 + 512), l1 = vtr(vp + AV_DH + kk * 1024), h1 = vtr(vp + AV_DH + kk * 1024 + 512);
                o0 = __builtin_amdgcn_mfma_f32_32x32x16_bf16(pa, (bf16x8){l0[0], l0[1], l0[2], l0[3], h0[0], h0[1], h0[2], h0[3]}, o0, 0, 0, 0);
                o1 = __builtin_amdgcn_mfma_f32_32x32x16_bf16(pa, (bf16x8){l1[0], l1[1], l1[2], l1[3], h1[0], h1[1], h1[2], h1[3]}, o1, 0, 0, 0);
                ol = __builtin_amdgcn_mfma_f32_32x32x16_bf16(pa, ones, ol, 0, 0, 0); }
        }
        FA_BAR();
        const AUnit cur = a;
        if (i + 1 < n) { a = aunit_decode(P, u0 + i + 1); aunit_dma(a, lds, wid, lane); }
        pm_keep = m; pl_keep = ol; prev = cur; prev_uq = uq;
#pragma unroll
        for (int r = 0; r < 16; ++r) { const float il = 1.0f / ol[r]; const int orow = crow(r, hi);
            stg[orow * 64 + r32] = (bf16)f2bf(o0[r] * il); stg[orow * 64 + 32 + r32] = (bf16)f2bf(o1[r] * il); }
        if (i + 1 < n) { const bf16* qrow = a.Pb + (size_t)(a.c + ((a.U0 + 32 * wid + r32) << a.sh)) * NINP + COL_AQ + a.h * 64 + hi * 8;
#pragma unroll
            for (int k = 0; k < 4; ++k) qf[k] = *(const bf16x8*)(qrow + 16 * k); }
    }
    APAT_FLUSH();
#undef APAT_FLUSH
    asm volatile("s_waitcnt vmcnt(0) lgkmcnt(0)\n\ts_barrier" ::: "memory");
}
namespace fa {
constexpr int A2K_CH = 256 * 16, A2V_DH = 256 * 64, A2HALF = 65536;
__device__ __forceinline__ AUnit aunit2_decode(const bf16* P, int u) { const int bh = u / 96, rem = u % 96, pat = rem >> 5, blk = rem & 31, b = bh / 6, bpc = 32 >> (2 * pat);
    AUnit a; a.Pb = P + (size_t)b * S * NINP; a.h = bh % 6; a.sh = 2 * pat; a.c = blk / bpc; a.U0 = (blk % bpc) * 128; a.L = S >> a.sh; a.rowbase = (size_t)pat * M + (size_t)b * S; return a; }
__device__ __forceinline__ void aunit2_dma(const AUnit& a, LAS unsigned char* hb, int w4, int lane) {
#pragma unroll
    for (int j = 0; j < 8; ++j) { const int pid = w4 + 4 * j, ch = pid >> 2, rg = pid & 3; int u = a.U0 - 64 + 64 * rg + lane; u = u < 0 ? 0 : (u >= a.L ? a.L - 1 : u);
        glds16(a.Pb, (unsigned)((a.c + (u << a.sh)) * NINP + COL_AK + a.h * 64 + ch * 8) * 2u, lds_addr(hb + ch * A2K_CH + rg * 1024)); }
#pragma unroll
    for (int j = 0; j < 8; ++j) { const int pid = w4 + 4 * j, dh = pid >> 4, rg = pid & 15; int u = a.U0 - 64 + 16 * rg + (lane >> 2); u = u < 0 ? 0 : (u >= a.L ? a.L - 1 : u);
        glds16(a.Pb, (unsigned)((a.c + (u << a.sh)) * NINP + COL_AV + a.h * 64 + dh * 32 + (lane & 3) * 8) * 2u, lds_addr(hb + 32768 + dh * A2V_DH + rg * 1024)); }
}
__device__ __forceinline__ void half_bar(volatile LAS unsigned* cnt, unsigned& gen, int lane) {
    asm volatile("s_waitcnt lgkmcnt(0)" ::: "memory"); ++gen;
    if (lane == 0) __hip_atomic_fetch_add((LAS unsigned*)cnt, 1u, __ATOMIC_RELAXED, __HIP_MEMORY_SCOPE_WORKGROUP);
    for (unsigned sp = 0; *cnt < 4u * gen; ++sp) { __builtin_amdgcn_s_sleep(1); if (sp > (1u << 22)) break; }
    asm volatile("" ::: "memory");
}
}
__device__ __forceinline__ void ph_apat2(Frame& F, volatile LAS unsigned* MISC) {
    using namespace fa;
    unsigned char* ws = F.a->ws; const bf16* P = (const bf16*)(ws + WS_R1); bf16* PO = (bf16*)(ws + WS_AP); float* PM = (float*)(ws + WS_AP + AP_PO_BYTES); float* PL = (float*)(ws + WS_AP + AP_PO_BYTES + AP_ML_BYTES);
    const int tid = F.tid, lane = tid & 63, r32 = lane & 31, hi = lane >> 5, wid = __builtin_amdgcn_readfirstlane(tid >> 6), half = wid >> 2, w4 = wid & 3;
    LAS unsigned char* hb = F.lds + half * A2HALF;
    LAS float* wsf = (LAS float*)(F.lds + LDS_AP2 + 8 * 2048) + wid * 64; LAS bf16* stg = (LAS bf16*)(F.lds + LDS_AP2) + wid * 1024;
    volatile LAS unsigned* cnt = MISC + 8 + half; unsigned gen = 0u;
    const int e = F.vcu >> 1, odd = F.vcu & 1, n = odd ? 10 : 8, u0 = e * 36 + (odd ? 16 + 10 * half : 8 * half);
    const int vro = ((lane >> 4) & 1) * 32 + (lane & 3) * 8 + (4 * hi + ((lane & 15) >> 2)) * 64;
    const bf16x8 ones = (bf16x8){0x3F80, 0x3F80, 0x3F80, 0x3F80, 0x3F80, 0x3F80, 0x3F80, 0x3F80};
    if (tid == 0) { MISC[8] = 0u; MISC[9] = 0u; }
    asm volatile("s_waitcnt vmcnt(0) lgkmcnt(0)\n\ts_barrier" ::: "memory");
    AUnit a = aunit2_decode(P, u0); aunit2_dma(a, hb, w4, lane);
    bf16x8 qf[4];
    { const bf16* qrow = a.Pb + (size_t)(a.c + ((a.U0 + 32 * w4 + r32) << a.sh)) * NINP + COL_AQ + a.h * 64 + hi * 8;
#pragma unroll
      for (int k = 0; k < 4; ++k) qf[k] = *(const bf16x8*)(qrow + 16 * k); }
#pragma unroll 1
    for (int i = 0; i < n; ++i) {
        FA_WAITV(0); half_bar(cnt, gen, lane);
        const int uq = a.U0 + 32 * w4 + r32, L = a.L; const bool edge = a.U0 < 64 || a.U0 + 192 > L;
        float m = -1e30f; f32x16 o0 = f32x16{}, o1 = f32x16{}, ol = f32x16{};
#pragma unroll
        for (int j = 0; j < 3; ++j) {
            const int st0 = w4 + 2 * j;
            const lds_cptr kp0 = (lds_cptr)(hb + hi * A2K_CH + (32 * st0 + r32) * 16), kp1 = kp0 + 512;
            f32x16 p0 = f32x16{}, p1 = f32x16{};
#pragma unroll
            for (int k = 0; k < 4; ++k) { p0 = __builtin_amdgcn_mfma_f32_32x32x16_bf16(*(const LAS bf16x8*)(kp0 + 2 * k * A2K_CH), qf[k], p0, 0, 0, 0);
                if (j < 2) p1 = __builtin_amdgcn_mfma_f32_32x32x16_bf16(*(const LAS bf16x8*)(kp1 + 2 * k * A2K_CH), qf[k], p1, 0, 0, 0); }
            float rm = -INFINITY;
            if (edge) {
#pragma unroll
                for (int r = 0; r < 16; ++r) { const int d0 = 64 * j - 64 + crow(r, hi) - r32, k0 = uq + d0; const bool ok0 = d0 >= -64 && d0 <= 64 && k0 >= 0 && k0 < L; p0[r] = ok0 ? p0[r] : -INFINITY; rm = __builtin_fmaxf(rm, p0[r]);
                    if (j < 2) { const int d1 = d0 + 32, k1 = uq + d1; const bool ok1 = d1 >= -64 && d1 <= 64 && k1 >= 0 && k1 < L; p1[r] = ok1 ? p1[r] : -INFINITY; rm = __builtin_fmaxf(rm, p1[r]); } }
            } else {
#pragma unroll
                for (int r = 0; r < 16; ++r) { if (j == 0) p0[r] = crow(r, hi) >= r32 ? p0[r] : -INFINITY; if (j == 2) p0[r] = crow(r, hi) <= r32 ? p0[r] : -INFINITY;
                    rm = __builtin_fmaxf(rm, p0[r]); if (j < 2) rm = __builtin_fmaxf(rm, p1[r]); }
            }
            rm = swap_max(rm);
            if (__any(rm > m + 8.0f)) {
                const float mn = __builtin_fmaxf(m, rm), f = __builtin_amdgcn_exp2f(m - mn); m = mn; if (hi == 0) wsf[r32] = f;
#pragma unroll
                for (int r = 0; r < 16; ++r) { const float fr = wsf[crow(r, hi)]; o0[r] *= fr; o1[r] *= fr; ol[r] *= fr; } }
            u32x4 pw[4];
#pragma unroll
            for (int q = 0; q < 4; ++q) { pw[0][q] = cvtpk(__builtin_amdgcn_exp2f(p0[2 * q] - m), __builtin_amdgcn_exp2f(p0[2 * q + 1] - m)); pw[1][q] = cvtpk(__builtin_amdgcn_exp2f(p0[8 + 2 * q] - m), __builtin_amdgcn_exp2f(p0[9 + 2 * q] - m));
                if (j < 2) { pw[2][q] = cvtpk(__builtin_amdgcn_exp2f(p1[2 * q] - m), __builtin_amdgcn_exp2f(p1[2 * q + 1] - m)); pw[3][q] = cvtpk(__builtin_amdgcn_exp2f(p1[8 + 2 * q] - m), __builtin_amdgcn_exp2f(p1[9 + 2 * q] - m)); } }
            const lds_cptr vp = (lds_cptr)(hb + 32768 + 32 * st0 * 64 + vro);
#pragma unroll
            for (int kk = 0; kk < (j < 2 ? 4 : 2); ++kk) { const bf16x8 pa = __builtin_bit_cast(bf16x8, pw[kk]);
                const s16x4 l0 = vtr(vp + kk * 1024), h0 = vtr(vp + kk * 1024 + 512), l1 = vtr(vp + A2V_DH + kk * 1024), h1 = vtr(vp + A2V_DH + kk * 1024 + 512);
                o0 = __builtin_amdgcn_mfma_f32_32x32x16_bf16(pa, (bf16x8){l0[0], l0[1], l0[2], l0[3], h0[0], h0[1], h0[2], h0[3]}, o0, 0, 0, 0);
                o1 = __builtin_amdgcn_mfma_f32_32x32x16_bf16(pa, (bf16x8){l1[0], l1[1], l1[2], l1[3], h1[0], h1[1], h1[2], h1[3]}, o1, 0, 0, 0);
                ol = __builtin_amdgcn_mfma_f32_32x32x16_bf16(pa, ones, ol, 0, 0, 0); }
        }
        half_bar(cnt, gen, lane);
        const AUnit cur = a;
        if (i + 1 < n) { a = aunit2_decode(P, u0 + i + 1); aunit2_dma(a, hb, w4, lane); }
        if (hi == 0) PM[(cur.rowbase + (size_t)(cur.c + (uq << cur.sh))) * 6 + cur.h] = m;
        if (r32 == 0) {
#pragma unroll
            for (int r = 0; r < 16; ++r) PL[(cur.rowbase + (size_t)(cur.c + ((cur.U0 + 32 * w4 + crow(r, hi)) << cur.sh))) * 6 + cur.h] = ol[r]; }
#pragma unroll
        for (int ps = 0; ps < 2; ++ps) {
#pragma unroll
            for (int r = 0; r < 16; ++r) if ((crow(r, 0) >> 4) == ps) { const float il = 1.0f / ol[r]; const int orow = crow(r, hi) & 15;
                stg[orow * 64 + r32] = (bf16)f2bf(o0[r] * il); stg[orow * 64 + 32 + r32] = (bf16)f2bf(o1[r] * il); }
#pragma unroll
            for (int q = 0; q < 2; ++q) { const int row = q * 8 + (lane >> 3), ch = lane & 7; const u32x4 v = *(const LAS u32x4*)(stg + row * 64 + ch * 8);
                const size_t t = cur.rowbase + (size_t)(cur.c + ((cur.U0 + 32 * w4 + 16 * ps + row) << cur.sh)); *(u32x4*)(PO + (t * 6 + cur.h) * 64 + ch * 8) = v; }
        }
        if (i + 1 < n) { const bf16* qrow = a.Pb + (size_t)(a.c + ((a.U0 + 32 * w4 + r32) << a.sh)) * NINP + COL_AQ + a.h * 64 + hi * 8;
#pragma unroll
            for (int k = 0; k < 4; ++k) qf[k] = *(const bf16x8*)(qrow + 16 * k); }
    }
    asm volatile("s_waitcnt vmcnt(0) lgkmcnt(0)\n\ts_barrier" ::: "memory");
}
template <int NB_> __device__ __forceinline__ void ph_acomb(Frame& F, int wg, int nwg, int lo, int hi) {
    unsigned char* ws = F.a->ws; const bf16* PO = (const bf16*)(ws + WS_AP); const float* PM = (const float*)(ws + WS_AP + AP_PO_BYTES); const float* PL = (const float*)(ws + WS_AP + AP_PO_BYTES + AP_ML_BYTES); bf16* O = (bf16*)(ws + WS_O);
    const int stride = nwg * NTHR;
#pragma unroll 1
    for (int i0 = lo + wg * NTHR + F.tid; i0 < hi; i0 += NB_ * stride) {
        float mm[NB_][3], ll[NB_][3]; u32x4 pv[NB_][3];
#pragma unroll
        for (int u = 0; u < NB_; ++u) { const int iu = i0 + u * stride, i = iu < hi ? iu : i0, th = i >> 3, ch = i & 7;
#pragma unroll
            for (int p = 0; p < 3; ++p) { mm[u][p] = PM[(size_t)p * M * 6 + th]; ll[u][p] = PL[(size_t)p * M * 6 + th]; pv[u][p] = *(const u32x4*)(PO + ((size_t)p * M * 6 + th) * 64 + ch * 8); } }
#pragma unroll
        for (int u = 0; u < NB_; ++u) { const int iu = i0 + u * stride, i = iu < hi ? iu : i0, th = i >> 3, ch = i & 7, t = th / 6, h = th % 6;
            const float mx = fmaxf(mm[u][0], fmaxf(mm[u][1], mm[u][2]));
            float den = 0.f, acc[8];
#pragma unroll
            for (int j = 0; j < 8; ++j) acc[j] = 0.f;
#pragma unroll
            for (int p = 0; p < 3; ++p) { const float w = exp2f(mm[u][p] - mx) * ll[u][p]; den += w; const u32x4 q = pv[u][p];
                acc[0] += w * bf2f(q.x & 0xffffu); acc[1] += w * bf2f(q.x >> 16); acc[2] += w * bf2f(q.y & 0xffffu); acc[3] += w * bf2f(q.y >> 16);
                acc[4] += w * bf2f(q.z & 0xffffu); acc[5] += w * bf2f(q.z >> 16); acc[6] += w * bf2f(q.w & 0xffffu); acc[7] += w * bf2f(q.w >> 16); }
            const float id = 1.0f / den; float ss = 0.f;
#pragma unroll
            for (int j = 0; j < 8; ++j) { acc[j] *= id; ss += acc[j] * acc[j]; }
            ss += __shfl_xor(ss, 1); ss += __shfl_xor(ss, 2); ss += __shfl_xor(ss, 4);
            const float rstd = 1.0f / sqrtf(ss * (1.0f / 64.0f) + 1e-6f);
#pragma unroll
            for (int j = 0; j < 8; ++j) acc[j] *= rstd;
            if (iu < hi) store8(O + (size_t)t * D + h * 64 + ch * 8, acc); }
    }
}
#ifndef MK_SPLIT
#define MK_SPLIT 0
#endif
__global__ void __launch_bounds__(NTHR, 2) mk_fwd(Args args) {
    extern __shared__ __attribute__((aligned(16))) unsigned char lds_raw[];
    Frame F; F.lds = (LAS unsigned char*)lds_raw; F.tid = threadIdx.x; F.lane = F.tid & 63; F.wave = __builtin_amdgcn_readfirstlane(F.tid >> 6);
    { const int bx = blockIdx.x; F.vcu = (bx % 8) * (GRID / 8) + bx / 8; } F.gw = F.vcu * NWAVES + F.wave; F.a = (CArgs*)__builtin_amdgcn_kernarg_segment_ptr();
    volatile LAS unsigned* MISC = (volatile LAS unsigned*)(F.lds + LDS_MISC);
    if (F.tid < 32) MISC[F.tid] = 0u;
    __syncthreads();
#if !MK_SPLIT
    XcdBarrier bar = xcd_barrier_post((unsigned*)(args.ws + WS_CTL) + CW_BAR, MISC);
#define GRID_BAR() do { PH_BEGIN(); xcd_barrier(bar, F.tid); } while (0)
#else
#define GRID_BAR() do {} while (0)
#endif
    const int lo = args.ph_lo, hi = args.ph_hi;
#define IN(k) (lo <= (k) && (k) < hi)
#define PH_BEGIN() do { int t_ = (int)__builtin_amdgcn_mbcnt_hi(~0u, __builtin_amdgcn_mbcnt_lo(~0u, 0u)); int w_ = F.wave; CArgs* a_ = (CArgs*)__builtin_amdgcn_kernarg_segment_ptr(); asm volatile("" : "+v"(t_), "+s"(w_), "+s"(a_)); F.wave = w_; F.lane = t_; F.tid = w_ * 64 + t_; F.a = a_; } while (0)
#define SEAM(k) do { if (IN(k) && IN((k) + 1)) GRID_BAR(); } while (0)
    LAS int* rows = (LAS int*)(F.lds + LDS_ROWS); LAS float* rs = (LAS float*)(F.lds + LDS_RS);
#define ws (F.a->ws)
#define XN ((bf16*)(ws + WS_X))
#define P ((bf16*)(ws + WS_R1))
#define ACT ((bf16*)(ws + WS_R1))
#define U ((bf16*)(ws + WS_R2))
#define O ((bf16*)(ws + WS_O))
#define Y ((bf16*)(ws + WS_R2))
#define TAB ((const float*)(ws + WS_TAB))
    for (int l = 0; l < DEPTH; ++l) {
        const int pb = 8 * l;
        if (IN(pb + 0)) { PH_BEGIN(); if (l == 0) ph_tab(F); if (F.a->sub & 1) ph_wconv(F, l, 0, F.gw, GRID * NWAVES); if (F.a->sub & 2) ph_entry(F, l == 0 ? 0 : 1); }
        SEAM(pb + 0);
        if (IN(pb + 1)) { PH_BEGIN(); pg8::Gemm g{XN, (const bf16*)(ws + WS_WIN), D, D, D}; pg8::PanelOrder<false> Sd{F.vcu >> 1, 5 * (F.vcu & 1), 5, (size_t)256 * D * 2, (size_t)256 * D * 2, 0, nullptr};
            pg8::EpiIn E{P, TAB, (const float*)(ws + WS_RSTDA)}; pg8::gemm_phase<pg8::EpiIn, pg8::PanelOrder<false>, false>(F.lds, g, Sd, E, F.tid); }
        SEAM(pb + 1);
        if (IN(pb + 2)) { PH_BEGIN(); const int pm = F.vcu >> 1; if (F.a->sub & 1) {
            { const int r = F.tid >> 1, part = F.tid & 1; const bf16* pr = P + (size_t)(pm * 256 + r) * NINP + (part ? COL_CKV : COL_CQ); const int nch = part ? 16 : 24; float s = 0.f;
#pragma unroll 1
                for (int c0 = 0; c0 < nch; c0 += 8) { u32x4 w[8];
#pragma unroll
                    for (int c = 0; c < 8; ++c) w[c] = *(const u32x4*)(pr + 8 * (c0 + c));
#pragma unroll
                    for (int c = 0; c < 8; ++c) { const float a0 = bf2f(w[c].x & 0xffffu), a1 = bf2f(w[c].x >> 16), a2 = bf2f(w[c].y & 0xffffu), a3 = bf2f(w[c].y >> 16), a4 = bf2f(w[c].z & 0xffffu), a5 = bf2f(w[c].z >> 16), a6 = bf2f(w[c].w & 0xffffu), a7 = bf2f(w[c].w >> 16);
                        s += (a0 * a0 + a1 * a1) + (a2 * a2 + a3 * a3) + (a4 * a4 + a5 * a5) + (a6 * a6 + a7 * a7); } }
                rs[2 * r + part] = part ? 1.0f / sqrtf(s * (1.0f / 128.0f) + 1e-6f) : QS_C / sqrtf(s * (1.0f / 192.0f) + 1e-6f); }
            __syncthreads();
            pg8::Gemm g{P + COL_CQ, (const bf16*)(ws + WS_WUP), NINP, KUP, KUP}; pg8::PanelOrder<false> Sd{pm, (F.vcu & 1) ? 3 : 0, (F.vcu & 1) ? 2 : 3, (size_t)256 * NINP * 2, (size_t)256 * KUP * 2, 0, nullptr};
            pg8::EpiUp E{U, TAB, rs}; pg8::gemm_phase<pg8::EpiUp, pg8::PanelOrder<false>, true>(F.lds, g, Sd, E, F.tid); } if (F.a->sub & 2) { PH_BEGIN(); ph_apat2(F, MISC); } }
        SEAM(pb + 2);
        if (IN(pb + 3)) { PH_BEGIN(); constexpr int ACN = M * 6 * 8, ACS = (int)((long)ACN * ACOMB_DED / 100) & ~4095;
            if ((F.vcu & 31) >= 32 - NWC) { if (F.a->sub & 1) { const int dw = (F.vcu >> 5) * NWC + (F.vcu & 31) - (32 - NWC);
                ph_wconv(F, l, 1, dw * NWAVES + F.wave, 8 * NWC * NWAVES); PH_BEGIN(); ph_acomb<4>(F, dw, 8 * NWC, 0, ACS); } }
            else { if (F.a->sub & 1) { ph_acomb<2>(F, (F.vcu >> 5) * (32 - NWC) + (F.vcu & 31), 8 * (32 - NWC), ACS, ACN); PH_BEGIN(); } ph_attn_bc(F, l); } }
        SEAM(pb + 3);
        if (IN(pb + 4)) { PH_BEGIN(); pg8::Gemm g{O, (const bf16*)(ws + WS_WOUT), D, D, D}; pg8::PanelOrder<false> Sd{F.vcu >> 1, 2 * (F.vcu & 1), 2, (size_t)256 * D * 2, (size_t)256 * D * 2, 0, nullptr};
            pg8::EpiOut E{XN, l == 0 ? F.a->in[0] : (const float*)nullptr}; pg8::gemm_phase<pg8::EpiOut, pg8::PanelOrder<false>, true>(F.lds, g, Sd, E, F.tid); }
        SEAM(pb + 4);
        if (IN(pb + 5)) { PH_BEGIN(); ph_router(F, l); }
        SEAM(pb + 5);
        if (IN(pb + 6)) { PH_BEGIN(); const int e = F.vcu >> 4, b = (F.vcu >> 1) & 7, half = F.vcu & 1;
            topk_select(F, b, e, half, rows);
            pg8::Gemm g{XN, (const bf16*)(ws + WS_WGU), D, D, D}; pg8::PairOrder<true> Sd{F.vcu & ~1, half, 11, 6, 0, (size_t)256 * D * 2, (size_t)e * NGU * D * 2, rows};
            pg8::EpiG1 E{ACT, (const float*)(ws + WS_RSTD), rows}; pg8::gemm_phase<pg8::EpiG1, pg8::PairOrder<true>, false>(F.lds, g, Sd, E, F.tid); }
        if (IN(pb + 6) && IN(pb + 7)) { PH_BEGIN(); asm volatile("s_waitcnt vmcnt(0)" ::: "memory"); __syncthreads();
            if (F.tid == 0) { unsigned* ctr = (unsigned*)(ws + WS_CTL) + CW_PAIR + 64 * (128 * l + (F.vcu >> 1)); unsigned* tmo = (unsigned*)(ws + WS_CTL) + CW_BAR;
                __builtin_amdgcn_fence(__ATOMIC_RELEASE, "agent"); asm volatile("s_waitcnt vmcnt(0)" ::: "memory");
                xb_add(ctr, 1u); XB_SPIN(xb_ld(ctr) < 2u, tmo);
                __builtin_amdgcn_fence(__ATOMIC_ACQUIRE, "agent"); asm volatile("s_waitcnt vmcnt(0)" ::: "memory"); }
            __syncthreads(); }
        if (IN(pb + 7)) { PH_BEGIN(); const int e = F.vcu >> 4;
            pg8::Gemm g{ACT, (const bf16*)(ws + WS_WD), FF, FF, FF}; pg8::PairOrder<false> Sd{F.vcu & ~1, F.vcu & 1, 4, 2, (size_t)256 * FF * 2, (size_t)256 * FF * 2, (size_t)e * D * FF * 2, nullptr};
            pg8::EpiBf16 E{Y, D}; pg8::gemm_phase<pg8::EpiBf16, pg8::PairOrder<false>, false>(F.lds, g, Sd, E, F.tid); }
        SEAM(pb + 7);
    }
    if (IN(8 * DEPTH)) { PH_BEGIN(); ph_entry(F, 2); }
#undef IN
#undef SEAM
#undef ws
#undef XN
#undef P
#undef ACT
#undef U
#undef O
#undef Y
#undef TAB
}

extern "C" void kernel_launch(void* const* d_in, const int* in_sizes, int n_in, void* d_out, int out_size, void* d_ws, size_t ws_size, hipStream_t stream) {
    static int ready = 0;
    if (ready == 0) {
        if (n_in != 22 || out_size != M * D || ws_size < WS_END) { fprintf(stderr, "kernel_launch: unexpected shapes (n_in %d out %d ws %zu)\n", n_in, out_size, ws_size); ready = -1; return; }
        int dev = 0, cus = 0, per_cu = 0; hipGetDevice(&dev); hipDeviceGetAttribute(&cus, hipDeviceAttributeMultiprocessorCount, dev);
        if (hipFuncSetAttribute((const void*)mk_fwd, hipFuncAttributeMaxDynamicSharedMemorySize, LDS_BYTES) != hipSuccess) { fprintf(stderr, "kernel_launch: hipFuncSetAttribute failed\n"); ready = -1; return; }
        hipOccupancyMaxActiveBlocksPerMultiprocessor(&per_cu, (const void*)mk_fwd, NTHR, LDS_BYTES); (void)hipGetLastError();
        if (cus < GRID || per_cu < 1) fprintf(stderr, "kernel_launch: note: %d CUs, occupancy %d; the grid is %d workgroups, one per CU\n", cus, per_cu, GRID);
        ready = 1;
    }
    if (ready < 0) return;
    hipMemsetAsync((char*)d_ws + WS_CTL, 0, CTL_BYTES, stream);
    Args a{}; for (int i = 0; i < 22; ++i) a.in[i] = (const float*)d_in[i];
    a.out = (float*)d_out; a.ws = (unsigned char*)d_ws;
    a.sub = 7;
#if MK_SPLIT
    for (int ph = 0; ph < NPHASE; ++ph) { a.ph_lo = ph; a.ph_hi = ph + 1; a.sub = 7; hipLaunchKernelGGL(mk_fwd, dim3(GRID), dim3(NTHR), LDS_BYTES, stream, a);
        if (PROBE_DUP >= 0 && ((ph < 8 * DEPTH && (ph & 7) == PROBE_DUP) || ph == PROBE_DUP)) { a.sub = PROBE_SUB; for (int r = 0; r < PROBE_REPS; ++r) hipLaunchKernelGGL(mk_fwd, dim3(GRID), dim3(NTHR), LDS_BYTES, stream, a); } }
#else
    a.ph_lo = 0; a.ph_hi = NPHASE; hipLaunchKernelGGL(mk_fwd, dim3(GRID), dim3(NTHR), LDS_BYTES, stream, a);
#endif
}
```
